# Optimizing an MI355X kernel written in HIP

```python
import math
import jax, jax.numpy as jnp
from jax import lax
import numpy as np

D_MODEL = 1024
BATCH = 8
SEQ = 4096
DEPTH = 2

PLE_DIM = 256
EPS = 1e-6
A_HEADS = 8
A_HEAD_DIM = 64
A_WIDTH = A_HEADS * A_HEAD_DIM
MOBA_BLOCK = 256
MOBA_TOPK = 3
MOBA_QCHUNK = 32
ROPE_THETA = 500000.0
ROPE_DIM = A_HEAD_DIM // 4
B_HEADS = 4
B_QK_DIM = 128
B_V_DIM = 128
B_WIDTH = B_HEADS * B_V_DIM
RET_CHUNK = 128
RET_THETA = 10000.0
C_HEADS = 8
C_HEAD_DIM = 64
C_WIDTH = C_HEADS * C_HEAD_DIM
C_DECAY_RANK = 64
C_ICLR_RANK = 64
C_GATE_RANK = 128
C_VRES_RANK = 32
C_GN_EPS = C_HEAD_DIM * 1e-5
N_BRANCH = 3
MIX_WIDTH = 512
D_FF = -(-8 * D_MODEL // (3 * 256)) * 256
A_COLS = 3 * A_WIDTH
B_COLS = 2 * B_HEADS * B_QK_DIM + 2 * B_WIDTH
C_COLS = 3 * C_WIDTH + C_DECAY_RANK + C_ICLR_RANK + C_GATE_RANK
G_COLS = N_BRANCH * D_MODEL
N_IN = A_COLS + B_COLS + C_COLS + G_COLS

kernel_name = "hybrid_moba_retention_rwkv7_gated_block"


def split_cols(z, sizes):
    return jnp.split(z, np.cumsum(sizes)[:-1].tolist(), axis=-1)


def rms_norm(x, g):
    xf = x.astype(jnp.float32)
    y = xf * lax.rsqrt(jnp.mean(xf * xf, -1, keepdims=True) + EPS)
    return (y * g.astype(jnp.float32)).astype(x.dtype)


def head_norm(y, eps):
    yf = y.astype(jnp.float32)
    mu = jnp.mean(yf, -1, keepdims=True)
    var = jnp.mean(jnp.square(yf - mu), -1, keepdims=True)
    return (yf - mu) * lax.rsqrt(var + eps)


def lerp_shift(z, mu):
    z_prev = jnp.pad(z, ((0, 0), (1, 0), (0, 0)))[:, :-1]
    return z + (z_prev - z) * mu


def partial_rope(x, cos, sin):
    xr, xp = x[..., :ROPE_DIM], x[..., ROPE_DIM:]
    x1, x2 = xr[..., :ROPE_DIM // 2], xr[..., ROPE_DIM // 2:]
    c, s = cos.astype(x.dtype), sin.astype(x.dtype)
    return jnp.concatenate([x1 * c - x2 * s, x1 * s + x2 * c, xp], -1)


def pair_rotate(x, cos, sin):
    xe, xo = x[..., 0::2], x[..., 1::2]
    c, s = cos.astype(x.dtype), sin.astype(x.dtype)
    return jnp.stack([xe * c - xo * s, xe * s + xo * c], -1).reshape(x.shape)


def moba_attention(q, k, v, cos, sin):
    B, S, H, Dh = q.shape
    q = partial_rope(q.transpose(0, 2, 1, 3), cos, sin)
    k = partial_rope(k.transpose(0, 2, 1, 3), cos, sin)
    v = v.transpose(0, 2, 1, 3)
    nb = -(-S // MOBA_BLOCK)
    pad = nb * MOBA_BLOCK - S
    kb = jnp.pad(k, ((0, 0), (0, 0), (0, pad), (0, 0))).reshape(B, H, nb, MOBA_BLOCK, Dh)
    vb = jnp.pad(v, ((0, 0), (0, 0), (0, pad), (0, 0))).reshape(B, H, nb, MOBA_BLOCK, Dh)
    k_mean = jnp.mean(kb.astype(jnp.float32), axis=3)
    gate = jnp.einsum('bhsd,bhnd->bhsn', q.astype(jnp.float32), k_mean)
    q_blk = jnp.arange(S) // MOBA_BLOCK
    past = jnp.arange(nb)[None, :] < q_blk[:, None]
    gate = jnp.where(past, gate, -jnp.inf)
    topk = min(MOBA_TOPK, nb)
    sel_score, sel_idx = lax.top_k(gate, topk)
    sel_valid = jnp.isfinite(sel_score)

    nqc = S // MOBA_QCHUNK

    def to_chunks(t):
        t = t.reshape((B, H, nqc, MOBA_QCHUNK) + t.shape[3:])
        return jnp.moveaxis(t, 2, 0)

    bi = jnp.arange(B)[:, None, None, None]
    hi = jnp.arange(H)[None, :, None, None]
    scale = Dh ** -0.5
    n_sel = topk * MOBA_BLOCK

    def chunk(args):
        c, qc, idx, valid = args
        kg = kb[bi, hi, idx]
        vg = vb[bi, hi, idx]
        blk = (c * MOBA_QCHUNK) // MOBA_BLOCK
        k_own = lax.dynamic_index_in_dim(kb, blk, axis=2, keepdims=False)
        v_own = lax.dynamic_index_in_dim(vb, blk, axis=2, keepdims=False)
        s_sel = jnp.einsum('bhqd,bhqnkd->bhqnk', qc, kg).astype(jnp.float32) * scale
        s_sel = jnp.where(valid[..., None], s_sel, -jnp.inf)
        s_own = jnp.einsum('bhqd,bhkd->bhqk', qc, k_own).astype(jnp.float32) * scale
        q_pos = c * MOBA_QCHUNK + jnp.arange(MOBA_QCHUNK)
        k_pos = blk * MOBA_BLOCK + jnp.arange(MOBA_BLOCK)
        s_own = jnp.where(k_pos[None, :] <= q_pos[:, None], s_own, -jnp.inf)
        s = jnp.concatenate([s_sel.reshape(B, H, MOBA_QCHUNK, n_sel), s_own], -1)
        pr = jax.nn.softmax(s, axis=-1).astype(v.dtype)
        p_sel = pr[..., :n_sel].reshape(B, H, MOBA_QCHUNK, topk, MOBA_BLOCK)
        p_own = pr[..., n_sel:]
        return (jnp.einsum('bhqnk,bhqnkd->bhqd', p_sel, vg)
                + jnp.einsum('bhqk,bhkd->bhqd', p_own, v_own))

    out = lax.map(chunk, (jnp.arange(nqc), to_chunks(q), to_chunks(sel_idx), to_chunks(sel_valid)))
    out = jnp.moveaxis(out, 0, 2).reshape(B, H, S, Dh)
    return out.transpose(0, 2, 1, 3).reshape(B, S, H * Dh)


def retention(q, k, v, g, cos, sin):
    B, S, H, dk = q.shape
    dv = v.shape[-1]
    q = pair_rotate(q.transpose(0, 2, 1, 3), cos, sin)
    k = pair_rotate(k.transpose(0, 2, 1, 3), cos, sin) * (dk ** -0.5)
    v = v.transpose(0, 2, 1, 3)
    log_gamma = jnp.log(1.0 - 2.0 ** (-5.0 - jnp.arange(H, dtype=jnp.float32)))
    C = RET_CHUNK
    nc = S // C
    qc = q.reshape(B, H, nc, C, dk)
    kc = k.reshape(B, H, nc, C, dk)
    vc = v.reshape(B, H, nc, C, dv)
    i = jnp.arange(C, dtype=jnp.float32)
    diff = i[:, None] - i[None, :]
    decay_mask = jnp.where(diff >= 0, jnp.exp(log_gamma[:, None, None] * jnp.maximum(diff, 0.0)), 0.0)
    qk = jnp.einsum('bhnid,bhnjd->bhnij', qc, kc) * decay_mask[None, :, None]
    y_inner = jnp.einsum('bhnij,bhnje->bhnie', qk, vc)
    zeta = jnp.exp(log_gamma[:, None] * (C - 1 - i))
    kv = jnp.einsum('bhnjd,bhnje->bhnde', kc * zeta[None, :, None, :, None], vc).astype(jnp.float32)
    chunk_decay = jnp.exp(log_gamma * C)[None, :, None, None]

    def step(R, kv_n):
        return R * chunk_decay + kv_n, R

    _, R_prev = lax.scan(step, jnp.zeros((B, H, dk, dv), jnp.float32), jnp.moveaxis(kv, 2, 0))
    R_prev = jnp.moveaxis(R_prev, 0, 2)
    xi = jnp.exp(log_gamma[:, None] * (i + 1.0))
    y_cross = jnp.einsum('bhnid,bhnde->bhnie', qc.astype(jnp.float32), R_prev) * xi[None, :, None, :, None]
    y = (y_inner + y_cross).reshape(B, H, S, dv)
    y = head_norm(y, EPS).transpose(0, 2, 1, 3).reshape(B, S, H * dv)
    return (jax.nn.silu(g) * y).astype(g.dtype)


def rwkv7_scan(r, w, k, v, a, b):
    B, S, H, N = r.shape

    def step(state, inp):
        r_t, w_t, k_t, v_t, a_t, b_t = inp
        sa = jnp.einsum('bhvk,bhk->bhv', state, a_t)
        state = (state * w_t[:, :, None, :] + sa[..., None] * b_t[:, :, None, :]
                 + v_t[..., None] * k_t[:, :, None, :])
        return state, jnp.einsum('bhvk,bhk->bhv', state, r_t)

    xs = (jnp.moveaxis(r.astype(jnp.float32), 1, 0), jnp.moveaxis(w.astype(jnp.float32), 1, 0),
          jnp.moveaxis(k.astype(jnp.float32), 1, 0), jnp.moveaxis(v.astype(jnp.float32), 1, 0),
          jnp.moveaxis(a.astype(jnp.float32), 1, 0), jnp.moveaxis(b.astype(jnp.float32), 1, 0))
    _, y = lax.scan(step, jnp.zeros((B, H, N, N), jnp.float32), xs)
    return jnp.moveaxis(y, 0, 1)


def rwkv7_time_mix(r, k, v, w_lr, a_lr, g_lr, w0, w2, a0, a2, g2, k_k, k_a, r_k, ln_g, ln_b):
    B, S, _ = r.shape

    def heads(t):
        return t.reshape(B, S, C_HEADS, C_HEAD_DIM)

    w_log = -jax.nn.softplus(-(w0 + jnp.tanh(w_lr) @ w2)) - 0.5
    decay = jnp.exp(-jnp.exp(w_log.astype(jnp.float32)))
    a = jax.nn.sigmoid(a0 + a_lr @ a2)
    g = jax.nn.sigmoid(g_lr) @ g2
    kk = heads(k * k_k).astype(jnp.float32)
    kk = kk / jnp.maximum(jnp.sqrt(jnp.sum(kk * kk, -1, keepdims=True)), 1e-12)
    k = k * (1.0 + (a - 1.0) * k_a)
    y = rwkv7_scan(heads(r), heads(decay), heads(k), heads(v), -kk, kk * heads(a))
    y = head_norm(y, C_GN_EPS).reshape(B, S, C_WIDTH) * ln_g + ln_b
    bonus = jnp.sum(heads(r) * heads(k) * r_k, -1, keepdims=True) * heads(v)
    y = y + bonus.reshape(B, S, C_WIDTH)
    return (y * g).astype(r.dtype)


def setup_inputs(seed: int = 0) -> dict:
    key = jax.random.key(seed)
    kit = iter(list(jax.random.split(key, 32)))
    f32 = jnp.float32

    def nrm(shape, scale):
        return jax.random.normal(next(kit), shape, f32) * scale

    def unif(shape, lo, hi):
        return jax.random.uniform(next(kit), shape, f32, lo, hi)

    L, D = DEPTH, D_MODEL
    Lv = DEPTH - 1
    return {
        "x": nrm((BATCH, SEQ, D), 1.0),
        "p": nrm((DEPTH, BATCH, SEQ, PLE_DIM), 1.0),
        "norm_mix_g": 1.0 + nrm((L, D), 0.05),
        "w_in": nrm((L, D, N_IN), D ** -0.5),
        "c_mu": unif((L, C_COLS), 0.0, 1.0),
        "c_w0": unif((L, C_WIDTH), -6.0, -1.0),
        "c_w2": nrm((L, C_DECAY_RANK, C_WIDTH), 0.1),
        "c_a0": nrm((L, C_WIDTH), 0.1),
        "c_a2": nrm((L, C_ICLR_RANK, C_WIDTH), 0.1),
        "c_g2": nrm((L, C_GATE_RANK, C_WIDTH), C_GATE_RANK ** -0.5),
        "c_k_k": 0.85 + nrm((L, C_WIDTH), 0.05),
        "c_k_a": 1.0 + nrm((L, C_WIDTH), 0.05),
        "c_r_k": nrm((L, C_HEADS, C_HEAD_DIM), 0.1),
        "c_ln_g": 1.0 + nrm((L, C_WIDTH), 0.05),
        "c_ln_b": nrm((L, C_WIDTH), 0.01),
        "c_vres_down": nrm((Lv, D, C_VRES_RANK), D ** -0.5),
        "c_vres_mu": unif((Lv, C_VRES_RANK), 0.0, 1.0),
        "c_v0": nrm((Lv, C_WIDTH), 0.1),
        "c_v2": nrm((Lv, C_VRES_RANK, C_WIDTH), 0.1),
        "w_branch": nrm((L, N_BRANCH, MIX_WIDTH, D), MIX_WIDTH ** -0.5),
        "w_out": nrm((L, D, D), D ** -0.5),
        "norm_ffn_g": 1.0 + nrm((L, D), 0.05),
        "w_gate_up": nrm((L, D, 2 * D_FF), D ** -0.5),
        "w_down": nrm((L, D_FF, D), D_FF ** -0.5),
        "norm_ple_g": 1.0 + nrm((L, D), 0.05),
        "w_ple_gate": nrm((L, D, D), D ** -0.5),
        "w_ple_proj": nrm((L, PLE_DIM, D), PLE_DIM ** -0.5),
        "final_norm_g": 1.0 + nrm((D,), 0.05),
    }


def reference(x, p, norm_mix_g, w_in, c_mu, c_w0, c_w2, c_a0, c_a2, c_g2, c_k_k, c_k_a, c_r_k,
              c_ln_g, c_ln_b, c_vres_down, c_vres_mu, c_v0, c_v2, w_branch, w_out, norm_ffn_g,
              w_gate_up, w_down, norm_ple_g, w_ple_gate, w_ple_proj, final_norm_g):
    B, S, D = x.shape
    pos = jnp.arange(S, dtype=jnp.float32)
    inv_a = 1.0 / (ROPE_THETA ** (jnp.arange(0, ROPE_DIM, 2, dtype=jnp.float32) / ROPE_DIM))
    ang_a = pos[:, None] * inv_a[None, :]
    cos_a, sin_a = jnp.cos(ang_a), jnp.sin(ang_a)
    inv_b = 1.0 / (RET_THETA ** jnp.linspace(0.0, 1.0, B_QK_DIM // 2, dtype=jnp.float32))
    ang_b = pos[:, None] * inv_b[None, :]
    cos_b, sin_b = jnp.cos(ang_b), jnp.sin(ang_b)

    v_first = x[..., :C_WIDTH]
    for i in range(DEPTH):
        h = rms_norm(x, norm_mix_g[i])
        if i == 0:
            z = h @ w_in[0]
            za, zb, zc, zg = split_cols(z, [A_COLS, B_COLS, C_COLS, G_COLS])
        else:
            w_cat = jnp.concatenate([w_in[i], c_vres_down[i - 1]], axis=1)
            z = h @ w_cat
            za, zb, zc, zg, zv = split_cols(z, [A_COLS, B_COLS, C_COLS, G_COLS, C_VRES_RANK])

        qa, ka, va = split_cols(za, [A_WIDTH, A_WIDTH, A_WIDTH])
        hs_a = (B, S, A_HEADS, A_HEAD_DIM)
        y_a = moba_attention(qa.reshape(hs_a), ka.reshape(hs_a), va.reshape(hs_a), cos_a, sin_a)

        qb, kb, vb, gb = split_cols(zb, [B_HEADS * B_QK_DIM, B_HEADS * B_QK_DIM, B_WIDTH, B_WIDTH])
        y_b = retention(qb.reshape(B, S, B_HEADS, B_QK_DIM), kb.reshape(B, S, B_HEADS, B_QK_DIM),
                        vb.reshape(B, S, B_HEADS, B_V_DIM), gb, cos_b, sin_b)

        zc = lerp_shift(zc, c_mu[i])
        r_c, k_c, v_c, w_lr, a_lr, g_lr = split_cols(
            zc, [C_WIDTH, C_WIDTH, C_WIDTH, C_DECAY_RANK, C_ICLR_RANK, C_GATE_RANK])
        if i == 0:
            v_first = v_c
        else:
            v_lr = lerp_shift(zv, c_vres_mu[i - 1])
            v_c = v_c + (v_first - v_c) * jax.nn.sigmoid(c_v0[i - 1] + v_lr @ c_v2[i - 1])
        y_c = rwkv7_time_mix(r_c, k_c, v_c, w_lr, a_lr, g_lr, c_w0[i], c_w2[i], c_a0[i], c_a2[i],
                             c_g2[i], c_k_k[i], c_k_a[i], c_r_k[i], c_ln_g[i], c_ln_b[i])

        gates = jax.nn.sigmoid(zg.reshape(B, S, N_BRANCH, D))
        ys = jnp.stack([y_a, y_b, y_c], axis=2)
        branch = jnp.einsum('bsnc,ncd->bsnd', ys, w_branch[i])
        x = x + jnp.sum(gates * branch, axis=2) @ w_out[i]

        h = rms_norm(x, norm_ffn_g[i])
        gt, up = split_cols(h @ w_gate_up[i], [D_FF, D_FF])
        x = x + (jax.nn.silu(gt) * up) @ w_down[i]

        h = rms_norm(x, norm_ple_g[i])
        x = x + (p[i] @ w_ple_proj[i]) * jax.nn.sigmoid(h @ w_ple_gate[i])

    return rms_norm(x, final_norm_g)
```

```cpp
#include <hip/hip_runtime.h>
#include <hip/hip_cooperative_groups.h>
#include <cstdio>
#include <cstdint>
namespace cg = cooperative_groups;

#ifndef EN_ATT
#define EN_ATT 1
#endif
#ifndef EN_RET
#define EN_RET 1
#endif
#ifndef EN_RWKV
#define EN_RWKV 1
#endif

typedef unsigned short u16;
using bf16x8 = __attribute__((ext_vector_type(8))) short;
using s16x4  = __attribute__((ext_vector_type(4))) short;
using f32x16 = __attribute__((ext_vector_type(16))) float;
typedef float f2 __attribute__((ext_vector_type(2)));
typedef unsigned u32x4 __attribute__((ext_vector_type(4)));
typedef __bf16 bf2 __attribute__((ext_vector_type(2)));
#define DI __device__ __forceinline__
#define MFMA(a, b, c) __builtin_amdgcn_mfma_f32_32x32x16_bf16((a), (b), (c), 0, 0, 0)

constexpr int T_TOK = 32768, SEQ = 4096, DM = 1024, NBATCH = 8;
constexpr int DFF = 2816;
constexpr int ZA_W = 1536, ZB_W = 2048, ZC_W = 1824;
constexpr int N_INP = 5376;
constexpr int N_INP_PAD = 5504;
constexpr int SMEM_BYTES = 79872;
constexpr int NTHR = 256;

constexpr size_t MiB = 1048576ull;
constexpr size_t OFF_XB = 0;
constexpr size_t OFF_ZA = OFF_XB + 64 * MiB;
constexpr size_t OFF_ZB = OFF_ZA + 96 * MiB;
constexpr size_t OFF_ZC = OFF_ZB + 128 * MiB;
constexpr size_t OFF_YC = OFF_ZC + 114 * MiB;
constexpr size_t OFF_VF = OFF_YC + 32 * MiB;
constexpr size_t OFF_W  = OFF_VF + 32 * MiB;
constexpr size_t OFF_SM = OFF_W + 42 * MiB;
constexpr size_t OFF_MERGED = OFF_ZC;
constexpr size_t OFF_PB     = OFF_ZC + 64 * MiB;
constexpr size_t OFF_ACT    = OFF_ZA;
constexpr size_t OFF_ACTLR  = OFF_XB;
constexpr size_t W_IN  = 0;
constexpr size_t W_G   = W_IN + (size_t)N_INP_PAD * 1024;
constexpr size_t W_BR  = W_G + 3072ull * 1024;
constexpr size_t W_OUT = W_BR + 3ull * 1024 * 512;
constexpr size_t W_GU  = W_OUT + 1024ull * 1024;
constexpr size_t W_DN  = W_GU + 5632ull * 1024;
constexpr size_t W_PG  = W_DN + 1024ull * 2816;
constexpr size_t W_PP  = W_PG + 1024ull * 1024;
constexpr size_t W_W2  = W_PP + 1024ull * 256;
constexpr size_t W_A2  = W_W2 + 512ull * 64;
constexpr size_t W_G2  = W_A2 + 512ull * 64;
constexpr size_t W_V2  = W_G2 + 512ull * 128;
constexpr size_t W_END = W_V2 + 512ull * 32;
static_assert(W_END * 2 <= 42 * MiB, "weights region");
constexpr size_t SM_RSTD = 0;
constexpr size_t SM_KMEAN = SM_RSTD + 4ull * T_TOK;
constexpr size_t SM_COSA = SM_KMEAN + 4ull * 8 * 16 * 8 * 64;
constexpr size_t SM_SINA = SM_COSA + 4ull * 4096 * 8;
constexpr size_t SM_COSB = SM_SINA + 4ull * 4096 * 8;
constexpr size_t SM_SINB = SM_COSB + 4ull * 4096 * 64;
constexpr size_t SM_CNT  = SM_SINB + 4ull * 4096 * 64;
constexpr size_t SM_BAR  = SM_CNT + 256;
constexpr size_t SM_FLG  = SM_BAR + 4 * 3456;
constexpr size_t SM_XCH  = SM_FLG + 128 * 64;
constexpr size_t SM_END  = SM_XCH + 128 * 4 * 32 * 2 * 8;
static_assert(OFF_SM + SM_END <= 512 * MiB, "ws budget");

struct Params {
  const float* in[28];
  float* out;
  char* ws;
};

DI u16 f2bf(float x) { unsigned u = __float_as_uint(x); u += 0x7fffu + ((u >> 16) & 1u); return (u16)(u >> 16); }
DI float bf2f(u16 v) { return __uint_as_float(((unsigned)v) << 16); }
DI unsigned pack2(float a, float b) { f2 v = {a, b}; bf2 r = __builtin_convertvector(v, bf2); return __builtin_bit_cast(unsigned, r); }
DI float bflo(unsigned u) { return __uint_as_float(u << 16); }
DI float bfhi(unsigned u) { return __uint_as_float(u & 0xffff0000u); }
DI int tid_opaque() { int t = threadIdx.x; asm volatile("" : "+v"(t)); return t; }
DI void lds_barrier() { asm volatile("s_waitcnt lgkmcnt(0)\n\ts_barrier" ::: "memory"); }
DI int crow(int reg, int h) { return (reg & 3) + 8 * (reg >> 2) + 4 * h; }
DI float sigmoidf_(float x) { return 1.f / (1.f + __expf(-x)); }
template <int CTRL> DI float dpp_mov(float v) {
  return __builtin_bit_cast(float, __builtin_amdgcn_update_dpp(0, __builtin_bit_cast(int, v), CTRL, 0xF, 0xF, true));
}
DI float red8(float v) {
  v += dpp_mov<0xB1>(v); v += dpp_mov<0x4E>(v); v += dpp_mov<0x141>(v); return v;
}
DI bf16x8 pack8(float a0, float a1, float a2, float a3, float a4, float a5, float a6, float a7) {
  uint4 u = {pack2(a0, a1), pack2(a2, a3), pack2(a4, a5), pack2(a6, a7)};
  return __builtin_bit_cast(bf16x8, u);
}
DI s16x4 tr_read(const u16* p) {
  return __builtin_amdgcn_ds_read_tr16_b64_v4i16((__attribute__((address_space(3))) s16x4*)(p));
}
DI float fast_rcp(float x) { return __builtin_amdgcn_rcpf(x); }
DI float fsig(float x) { return fast_rcp(1.f + __expf(-x)); }
DI float ftanh(float x) { return 1.f - 2.f * fast_rcp(1.f + __expf(2.f * x)); }
DI void unpack8(u32x4 u, float (&o)[8]) {
  o[0] = bflo(u[0]); o[1] = bfhi(u[0]); o[2] = bflo(u[1]); o[3] = bfhi(u[1]);
  o[4] = bflo(u[2]); o[5] = bfhi(u[2]); o[6] = bflo(u[3]); o[7] = bfhi(u[3]);
}
DI bf16x8 cat44(s16x4 lo, s16x4 hi) { return __builtin_shufflevector(lo, hi, 0, 1, 2, 3, 4, 5, 6, 7); }
template <int MI>
DI void zero_acc(f32x16 (&acc)[MI][2]) {
#pragma unroll
  for (int i = 0; i < MI; i++)
#pragma unroll
    for (int j = 0; j < 2; j++)
#pragma unroll
      for (int r = 0; r < 16; r++) acc[i][j][r] = 0.f;
}

#define LDS_PTR(p) ((__attribute__((address_space(3))) void*)(p))
#define GLB_PTR(p) ((const __attribute__((address_space(1))) void*)(p))
template <int MI>
DI void gemm_pref(const u16* __restrict__ A, int lda, const u16* __restrict__ Bt, int ldb, int m0, int n0,
                  u32x4 (&pa)[2][4], u32x4 (&pb)[2][4]) {
  const int tid = tid_opaque();
  const int lrow = tid >> 3, lk = (tid & 7) * 8;
  const u16* ag = A + (size_t)(m0 + lrow) * lda + lk;
  const u16* bg = Bt + (size_t)(n0 + lrow) * ldb + lk;
#pragma unroll
  for (int st = 0; st < 2; st++) {
#pragma unroll
    for (int i = 0; i < 2 * MI; i++) pa[st][i] = *(const u32x4*)(ag + (size_t)st * 64 + (size_t)(32 * i) * lda);
#pragma unroll
    for (int i = 0; i < 4; i++) pb[st][i] = *(const u32x4*)(bg + (size_t)st * 64 + (size_t)(32 * i) * ldb);
  }
}
template <int MI>
DI void gemm_main(const u16* __restrict__ A, int lda, const u16* __restrict__ Bt, int ldb, int K,
                  int m0, int n0, f32x16 (&acc)[MI][2], char* smem, u32x4 (&pa)[2][4], u32x4 (&pb)[2][4]) {
  const int TX = tid_opaque();
  const int tid = TX, lane = tid & 63, w = tid >> 6, wr = w >> 1, wc = w & 1;
  const int l31 = lane & 31, h2 = lane >> 5;
  const int lrow = tid >> 3, lk = (tid & 7) * 8;
  const u16* ag = A + (size_t)(m0 + lrow) * lda + lk;
  const u16* bg = Bt + (size_t)(n0 + lrow) * ldb + lk;
  u16* sm = (u16*)smem;
#define G_LOAD(S, KT) do { const u16* a_ = ag + (size_t)(KT) * 64; const u16* b_ = bg + (size_t)(KT) * 64; \
    _Pragma("unroll") for (int i_ = 0; i_ < 2 * MI; i_++) pa[S][i_] = *(const u32x4*)(a_ + (size_t)(32 * i_) * lda); \
    _Pragma("unroll") for (int i_ = 0; i_ < 4; i_++) pb[S][i_] = *(const u32x4*)(b_ + (size_t)(32 * i_) * ldb); } while (0)
#define S_WRITE(S, BUF) do { u16* d_ = sm + (BUF) * 18432; \
    _Pragma("unroll") for (int i_ = 0; i_ < 2 * MI; i_++) *(u32x4*)(d_ + (lrow + 32 * i_) * 72 + lk) = pa[S][i_]; \
    _Pragma("unroll") for (int i_ = 0; i_ < 4; i_++) *(u32x4*)(d_ + 9216 + (lrow + 32 * i_) * 72 + lk) = pb[S][i_]; } while (0)
#define LDFRAG(KS, FA, FB0, FB1) do { \
      FB0 = *(const bf16x8*)(sB_ + (wc * 64 + l31) * 72 + (KS) * 16 + h2 * 8); \
      FB1 = *(const bf16x8*)(sB_ + (wc * 64 + 32 + l31) * 72 + (KS) * 16 + h2 * 8); \
      _Pragma("unroll") for (int mi = 0; mi < MI; mi++) FA[mi] = *(const bf16x8*)(sA_ + (wr * 32 * MI + mi * 32 + l31) * 72 + (KS) * 16 + h2 * 8); } while (0)
#define DOMMA(FA, FB0, FB1) do { _Pragma("unroll") for (int mi = 0; mi < MI; mi++) { \
      acc[mi][0] = MFMA(FA[mi], FB0, acc[mi][0]); acc[mi][1] = MFMA(FA[mi], FB1, acc[mi][1]); } } while (0)
#define COMPUTE(BUF) do { const u16* sA_ = sm + (BUF) * 18432; const u16* sB_ = sA_ + 9216; \
    bf16x8 fa0[MI], fa1[MI], fb00, fb01, fb10, fb11; \
    LDFRAG(0, fa0, fb00, fb01); \
    LDFRAG(1, fa1, fb10, fb11); \
    DOMMA(fa0, fb00, fb01); \
    LDFRAG(2, fa0, fb00, fb01); \
    DOMMA(fa1, fb10, fb11); \
    LDFRAG(3, fa1, fb10, fb11); \
    DOMMA(fa0, fb00, fb01); \
    DOMMA(fa1, fb10, fb11); } while (0)
  const int nk = K >> 6;
  __syncthreads();
  S_WRITE(0, 0);
  __syncthreads();
  for (int kt = 0; kt < nk; kt += 2) {
    if (kt + 2 < nk) G_LOAD(0, kt + 2);
    COMPUTE(0);
    S_WRITE(1, 1);
    __syncthreads();
    if (kt + 3 < nk) G_LOAD(1, kt + 3);
    COMPUTE(1);
    if (kt + 2 < nk) S_WRITE(0, 0);
    __syncthreads();
  }
#undef G_LOAD
#undef S_WRITE
#undef COMPUTE
#undef LDFRAG
#undef DOMMA
}
template <int MI>
DI void gemm_tile(const u16* __restrict__ A, int lda, const u16* __restrict__ Bt, int ldb, int K,
                  int m0, int n0, f32x16 (&acc)[MI][2], char* smem) {
  u32x4 pa[2][4], pb[2][4];
  gemm_pref<MI>(A, lda, Bt, ldb, m0, n0, pa, pb);
  gemm_main<MI>(A, lda, Bt, ldb, K, m0, n0, acc, smem, pa, pb);
}

DI void tile_coords(int t, int nN, int& m0, int& n0) {
  const int GM = 32;
  int per = GM * nN;
  int g = t / per, r = t - g * per;
  int n = r / GM, m = g * GM + (r - n * GM);
  m0 = m * 128; n0 = n * 128;
}

DI void conv_job(const float* __restrict__ src, int lds, int scol0, int K, int N, const float* __restrict__ gain,
                 u16* __restrict__ dst, int perm_gu, int gsz, int gid) {
  const int kg = K >> 3;
  const long total = (long)N * kg;
  for (long it = gid; it < total; it += gsz) {
    int n = (int)(it % N), k0 = (int)(it / N) * 8;
    int sc;
    if (perm_gu) { int blk = n >> 6, r = n & 63; int j = blk * 32 + (r & 31); sc = (r < 32) ? j : (DFF + j); }
    else sc = scol0 + n;
    float v[8];
#pragma unroll
    for (int i = 0; i < 8; i++) {
      float x = src[(size_t)(k0 + i) * lds + sc];
      if (gain) x *= gain[k0 + i];
      v[i] = x;
    }
    uint4 u = {pack2(v[0], v[1]), pack2(v[2], v[3]), pack2(v[4], v[5]), pack2(v[6], v[7])};
    *(uint4*)(dst + (size_t)n * K + k0) = u;
  }
}

DI void phase_convw(const Params& p, int l) {
  const int TX = tid_opaque();
  const int gsz = gridDim.x * NTHR, gid = blockIdx.x * NTHR + TX;
  u16* W = (u16*)(p.ws + OFF_W);
  const float* w_in = p.in[3] + (size_t)l * 1024 * 8448;
  const float* gmix = p.in[2] + l * 1024;
  conv_job(w_in, 8448, 0, 1024, N_INP, gmix, W + W_IN, 0, gsz, gid);
  if (l == 1) conv_job(p.in[15], 32, 0, 1024, 32, gmix, W + W_IN + (size_t)N_INP * 1024, 0, gsz, gid);
  {
    int r0 = (l == 1) ? N_INP + 32 : N_INP;
    long total = (long)(N_INP_PAD - r0) * 128;
    uint4 z = {0, 0, 0, 0};
    for (long it = gid; it < total; it += gsz) *(uint4*)(W + W_IN + (size_t)r0 * 1024 + it * 8) = z;
  }
  conv_job(w_in, 8448, N_INP, 1024, 3072, gmix, W + W_G, 0, gsz, gid);
  for (int n = 0; n < 3; n++)
    conv_job(p.in[19] + ((size_t)l * 3 + n) * 512 * 1024, 1024, 0, 512, 1024, nullptr, W + W_BR + (size_t)n * 1024 * 512, 0, gsz, gid);
  conv_job(p.in[20] + (size_t)l * 1024 * 1024, 1024, 0, 1024, 1024, nullptr, W + W_OUT, 0, gsz, gid);
  conv_job(p.in[22] + (size_t)l * 1024 * 5632, 5632, 0, 1024, 5632, p.in[21] + l * 1024, W + W_GU, 1, gsz, gid);
  conv_job(p.in[23] + (size_t)l * 2816 * 1024, 1024, 0, 2816, 1024, nullptr, W + W_DN, 0, gsz, gid);
  conv_job(p.in[25] + (size_t)l * 1024 * 1024, 1024, 0, 1024, 1024, p.in[24] + l * 1024, W + W_PG, 0, gsz, gid);
  conv_job(p.in[26] + (size_t)l * 256 * 1024, 1024, 0, 256, 1024, nullptr, W + W_PP, 0, gsz, gid);
  conv_job(p.in[6] + (size_t)l * 64 * 512, 512, 0, 64, 512, nullptr, W + W_W2, 0, gsz, gid);
  conv_job(p.in[8] + (size_t)l * 64 * 512, 512, 0, 64, 512, nullptr, W + W_A2, 0, gsz, gid);
  conv_job(p.in[9] + (size_t)l * 128 * 512, 512, 0, 128, 512, nullptr, W + W_G2, 0, gsz, gid);
  if (l == 1) conv_job(p.in[18], 512, 0, 32, 512, nullptr, W + W_V2, 0, gsz, gid);
  float* kmean = (float*)(p.ws + OFF_SM + SM_KMEAN);
  for (int i = gid; i < 8 * 16 * 8 * 64; i += gsz) kmean[i] = 0.f;
  if (gid < 16) ((int*)(p.ws + OFF_SM + SM_CNT))[gid] = 0;
  for (int i = gid; i < 128 * 4 * 32 * 4; i += gsz) ((unsigned*)(p.ws + OFF_SM + SM_XCH))[i] = 0u;
  if (l == 0) {
    float* ca = (float*)(p.ws + OFF_SM + SM_COSA); float* sa = (float*)(p.ws + OFF_SM + SM_SINA);
    float* cb = (float*)(p.ws + OFF_SM + SM_COSB); float* sb = (float*)(p.ws + OFF_SM + SM_SINB);
    for (int i = gid; i < 4096 * 8; i += gsz) {
      int pos = i >> 3, j = i & 7;
      float inv = 1.0f / powf(500000.0f, (float)(2 * j) / 16.0f);
      float ang = (float)pos * inv;
      ca[i] = cosf(ang); sa[i] = sinf(ang);
    }
    for (int i = gid; i < 4096 * 64; i += gsz) {
      int pos = i >> 6, j = i & 63;
      float inv = 1.0f / powf(10000.0f, (float)j / 63.0f);
      float ang = (float)pos * inv;
      cb[i] = cosf(ang); sb[i] = sinf(ang);
    }
  }
}

DI void phase_prep(const Params& p, const float* __restrict__ x, const float* __restrict__ pl) {
  const int TX = tid_opaque();
  const int lane = TX & 63;
  const int wid = blockIdx.x * (NTHR / 64) + (TX >> 6), nw = gridDim.x * (NTHR / 64);
  u16* XB = (u16*)(p.ws + OFF_XB);
  float* rstd = (float*)(p.ws + OFF_SM + SM_RSTD);
  for (int row = wid; row < T_TOK; row += nw) {
    const float4* xr = (const float4*)(x + (size_t)row * 1024);
    float ss = 0.f;
    float4 xv4[4];
#pragma unroll
    for (int i = 0; i < 4; i++) xv4[i] = xr[lane + 64 * i];
    float4 pv4 = {0.f, 0.f, 0.f, 0.f};
    if (pl) pv4 = ((const float4*)(pl + (size_t)row * 256))[lane];
#pragma unroll
    for (int i = 0; i < 4; i++) {
      const float4 v = xv4[i];
      ss += v.x * v.x + v.y * v.y + v.z * v.z + v.w * v.w;
      uint2 u = {pack2(v.x, v.y), pack2(v.z, v.w)};
      *(uint2*)(XB + (size_t)row * 1024 + (lane + 64 * i) * 4) = u;
    }
#pragma unroll
    for (int o = 32; o > 0; o >>= 1) ss += __shfl_xor(ss, o, 64);
    if (lane == 0) rstd[row] = rsqrtf(ss * (1.0f / 1024.0f) + 1e-6f);
    if (pl) {
      const float4 v = pv4;
      uint2 u = {pack2(v.x, v.y), pack2(v.z, v.w)};
      *(uint2*)((u16*)(p.ws + OFF_PB) + (size_t)row * 256 + lane * 4) = u;
    }
  }
}

DI void phase_final(const Params& p) {
  const int TX = tid_opaque();
  const int lane = TX & 63;
  const int wid = blockIdx.x * (NTHR / 64) + (TX >> 6), nw = gridDim.x * (NTHR / 64);
  const float4* g4 = (const float4*)p.in[27];
  for (int row = wid; row < T_TOK; row += nw) {
    float4* xr = (float4*)(p.out + (size_t)row * 1024);
    float4 v[4];
    float ss = 0.f;
#pragma unroll
    for (int i = 0; i < 4; i++) {
      v[i] = xr[lane + 64 * i];
      ss += v[i].x * v[i].x + v[i].y * v[i].y + v[i].z * v[i].z + v[i].w * v[i].w;
    }
#pragma unroll
    for (int o = 32; o > 0; o >>= 1) ss += __shfl_xor(ss, o, 64);
    float r = rsqrtf(ss * (1.0f / 1024.0f) + 1e-6f);
#pragma unroll
    for (int i = 0; i < 4; i++) {
      float4 g = g4[lane + 64 * i];
      float4 o = {v[i].x * r * g.x, v[i].y * r * g.y, v[i].z * r * g.z, v[i].w * r * g.w};
      xr[lane + 64 * i] = o;
    }
  }
}

DI void phase_inproj(const Params& p, int l, char* smem) {
  const int TX = tid_opaque();
  const u16* XB = (const u16*)(p.ws + OFF_XB);
  const u16* W = (const u16*)(p.ws + OFF_W) + W_IN;
  const float* rstd = (const float*)(p.ws + OFF_SM + SM_RSTD);
  const float* ca = (const float*)(p.ws + OFF_SM + SM_COSA); const float* sa = (const float*)(p.ws + OFF_SM + SM_SINA);
  const float* cb = (const float*)(p.ws + OFF_SM + SM_COSB); const float* sb = (const float*)(p.ws + OFF_SM + SM_SINB);
  u16* ZA = (u16*)(p.ws + OFF_ZA); u16* ZB = (u16*)(p.ws + OFF_ZB); u16* ZC = (u16*)(p.ws + OFF_ZC);
  const int nvalid = (l == 1) ? N_INP + 32 : N_INP;
  const int nN = (l == 1) ? 43 : 42;
  const int ntiles = 256 * nN;
  const int lane = TX & 63, w = TX >> 6, wr = w >> 1, wc = w & 1, l31 = lane & 31, h2 = lane >> 5;
  u32x4 pa[2][4], pb[2][4];
  int t = blockIdx.x, m0 = 0, n0 = 0;
  if (t < ntiles) { tile_coords(t, nN, m0, n0); gemm_pref<2>(XB, 1024, W, 1024, m0, n0, pa, pb); }
  for (; t < ntiles; t += gridDim.x) {
    f32x16 acc[2][2]; zero_acc<2>(acc);
    gemm_main<2>(XB, 1024, W, 1024, 1024, m0, n0, acc, smem, pa, pb);
    const int em0 = m0, en0 = n0;
    float rs[2][16];
#pragma unroll
    for (int mi = 0; mi < 2; mi++)
#pragma unroll
      for (int r = 0; r < 16; r++) rs[mi][r] = rstd[em0 + wr * 64 + mi * 32 + crow(r, h2)];
    if (t + (int)gridDim.x < ntiles) { tile_coords(t + gridDim.x, nN, m0, n0); gemm_pref<2>(XB, 1024, W, 1024, m0, n0, pa, pb); }
    u16* T = (u16*)smem;
#pragma unroll
    for (int ni = 0; ni < 2; ni++) {
      const int cbase = en0 + wc * 64 + ni * 32;
      if (cbase >= nvalid) continue;
      const int c = cbase + l31;
#pragma unroll
      for (int mi = 0; mi < 2; mi++) {
        const int rbase = em0 + wr * 64 + mi * 32;
        const int lrb = wr * 64 + mi * 32, lc = wc * 64 + ni * 32 + l31;
        if (cbase < 1024) {
          const int d = c & 63;
          const float invf = exp2f(-(float)(d & 7) * (18.931568569324174f / 8.0f));
          float cs[16], sn[16];
#pragma unroll
          for (int r = 0; r < 16; r++) {
            const float ang = (float)((rbase + crow(r, h2)) & (SEQ - 1)) * invf;
            float rev = ang * 0.15915494309189535f; rev = rev - floorf(rev);
            cs[r] = __builtin_amdgcn_cosf(rev); sn[r] = __builtin_amdgcn_sinf(rev);
          }
#pragma unroll
          for (int r = 0; r < 16; r++) {
            float v = acc[mi][ni][r] * rs[mi][r];
            float pv = __shfl_xor(v, 8, 64);
            if (d < 16) v = (d < 8) ? (v * cs[r] - pv * sn[r]) : (pv * sn[r] + v * cs[r]);
            if (cbase < 512) v *= 0.125f;
            T[(lrb + crow(r, h2)) * 136 + lc] = f2bf(v);
          }
        } else if (cbase < 1536) {
#pragma unroll
          for (int r = 0; r < 16; r++) T[(lrb + crow(r, h2)) * 136 + lc] = f2bf(acc[mi][ni][r] * rs[mi][r]);
        } else if (cbase < 2560) {
          const int cc = c - 1536;
          const int i2 = (cc & 127) >> 1;
          const float invf = exp2f(-(float)i2 * (13.287712379549449f / 63.0f));
          float cs[16], sn[16];
#pragma unroll
          for (int r = 0; r < 16; r++) {
            const float ang = (float)((rbase + crow(r, h2)) & (SEQ - 1)) * invf;
            float rev = ang * 0.15915494309189535f; rev = rev - floorf(rev);
            cs[r] = __builtin_amdgcn_cosf(rev); sn[r] = __builtin_amdgcn_sinf(rev);
          }
#pragma unroll
          for (int r = 0; r < 16; r++) {
            float v = acc[mi][ni][r] * rs[mi][r];
            float pv = __shfl_xor(v, 1, 64);
            v = (cc & 1) ? (pv * sn[r] + v * cs[r]) : (v * cs[r] - pv * sn[r]);
            if (cbase >= 2048) v *= 0.08838834764831845f;
            T[(lrb + crow(r, h2)) * 136 + lc] = f2bf(v);
          }
        } else if (cbase < 3584) {
#pragma unroll
          for (int r = 0; r < 16; r++) T[(lrb + crow(r, h2)) * 136 + lc] = f2bf(acc[mi][ni][r] * rs[mi][r]);
        } else {
#pragma unroll
          for (int r = 0; r < 16; r++) T[(lrb + crow(r, h2)) * 136 + lc] = f2bf(acc[mi][ni][r] * rs[mi][r]);
        }
      }
    }
    __syncthreads();
    {
      u16* dst; int pitch;
      if (en0 < 1536) { dst = ZA + en0; pitch = ZA_W; }
      else if (en0 < 3584) { dst = ZB + (en0 - 1536); pitch = ZB_W; }
      else { dst = ZC + (en0 - 3584); pitch = ZC_W; }
      const int vch = min(128, nvalid - en0) >> 3;
      u32x4 tv[8];
#pragma unroll
      for (int i = 0; i < 8; i++) { const int idx = TX + 256 * i; tv[i] = *(const u32x4*)(T + (idx >> 4) * 136 + (idx & 15) * 8); }
#pragma unroll
      for (int i = 0; i < 8; i++) {
        const int idx = TX + 256 * i, row = idx >> 4, chn = idx & 15;
        if (chn < vch) *(u32x4*)(dst + (size_t)(em0 + row) * pitch + chn * 8) = tv[i];
      }
    }
  }
}

DI void phase_kmean(const Params& p, char* smem) {
  const int TX = tid_opaque();
  const u16* ZA = (const u16*)(p.ws + OFF_ZA);
  float* kmean = (float*)(p.ws + OFF_SM + SM_KMEAN);
  float* red = (float*)smem;
  const int d = TX & 63, jg = TX >> 6;
  for (int it = blockIdx.x; it < 8 * 16 * 8; it += gridDim.x) {
    int h = it & 7, n = (it >> 3) & 15, b = it >> 7;
    const u16* base = ZA + ((size_t)(b * SEQ + n * 256 + jg * 64)) * ZA_W + 512 + h * 64 + d;
    float s = 0.f;
    for (int j = 0; j < 64; j++) s += bf2f(base[(size_t)j * ZA_W]);
    __syncthreads();
    red[jg * 64 + d] = s;
    __syncthreads();
    if (jg == 0) kmean[((b * 16 + n) * 8 + h) * 64 + d] = (red[d] + red[64 + d] + red[128 + d] + red[192 + d]) * (1.0f / 256.0f);
  }
}

DI void phase_lrprep(const Params& p, int l) {
  const int TX = tid_opaque();
  const u16* ZC = (const u16*)(p.ws + OFF_ZC);
  u16* ALR = (l == 0) ? (u16*)p.out : (u16*)(p.ws + OFF_ACTLR);
  const float* mu = p.in[4] + l * 1792 + 1536;
  const float* vmu = p.in[16];
  const int gsz = gridDim.x * NTHR, gid = blockIdx.x * NTHR + TX;
  for (int it = gid; it < T_TOK * 36; it += gsz) {
    const int row = it / 36, jg = it - row * 36, j0 = jg * 8;
    float out[8];
    if (j0 >= 256 && l == 0) {
#pragma unroll
      for (int e = 0; e < 8; e++) out[e] = 0.f;
    } else {
      const int col = (j0 < 256) ? (1536 + j0) : (1792 + (j0 - 256));
      const float* mup = (j0 < 256) ? (mu + j0) : (vmu + (j0 - 256));
      u32x4 cu = *(const u32x4*)(ZC + (size_t)row * ZC_W + col);
      u32x4 pu = {0u, 0u, 0u, 0u};
      if ((row & (SEQ - 1)) > 0) pu = *(const u32x4*)(ZC + (size_t)(row - 1) * ZC_W + col);
      float cv[8], pv[8];
      unpack8(cu, cv); unpack8(pu, pv);
#pragma unroll
      for (int e = 0; e < 8; e++) {
        float z = cv[e] + (pv[e] - cv[e]) * mup[e];
        if (j0 < 64) z = ftanh(z);
        else if (j0 >= 128 && j0 < 256) z = fsig(z);
        out[e] = z;
      }
    }
    u32x4 u = {pack2(out[0], out[1]), pack2(out[2], out[3]), pack2(out[4], out[5]), pack2(out[6], out[7])};
    *(u32x4*)(ALR + (size_t)row * 288 + j0) = u;
  }
}

DI void attn_item(const Params& p, int b, int h, int qt, char* smem) {
  const int TX = tid_opaque();
  u16* ZA = (u16*)(p.ws + OFF_ZA);
  const float* kmean = (const float*)(p.ws + OFF_SM + SM_KMEAN);
  const int tid = TX, lane = tid & 63, w = tid >> 6, l31 = lane & 31, h2 = lane >> 5;
  const int qblk = qt >> 1, r0 = (qt & 1) * 128;
  u16* sm = (u16*)smem;
  float* km = (float*)(smem + 36864);
  unsigned* uni = (unsigned*)(smem + 40960);
  __syncthreads();
  for (int i = tid; i < qblk * 64; i += NTHR) {
    int n = i >> 6, d = i & 63;
    km[i] = kmean[((b * 16 + n) * 8 + h) * 64 + d];
  }
  if (tid == 0) *uni = 0u;
  const size_t rowbase = (size_t)b * SEQ;
  const int qrow = qblk * 256 + r0 + w * 32 + l31;
  bf16x8 qf[4];
#pragma unroll
  for (int s = 0; s < 4; s++) qf[s] = *(const bf16x8*)(ZA + (rowbase + qrow) * ZA_W + h * 64 + 16 * s + 8 * h2);
  __syncthreads();
  unsigned selmask = 0;
  {
    float qv[32];
#pragma unroll
    for (int s = 0; s < 4; s++)
#pragma unroll
      for (int j = 0; j < 8; j++) qv[s * 8 + j] = bf2f((u16)qf[s][j]);
    float g[15];
#pragma unroll
    for (int n = 0; n < 15; n++) {
      float a = 0.f;
      if (n < qblk) {
#pragma unroll
        for (int s = 0; s < 4; s++) {
          const float4* kp = (const float4*)(km + n * 64 + 16 * s + 8 * h2);
          float4 k0 = kp[0], k1 = kp[1];
          a += qv[s * 8 + 0] * k0.x + qv[s * 8 + 1] * k0.y + qv[s * 8 + 2] * k0.z + qv[s * 8 + 3] * k0.w
             + qv[s * 8 + 4] * k1.x + qv[s * 8 + 5] * k1.y + qv[s * 8 + 6] * k1.z + qv[s * 8 + 7] * k1.w;
        }
      }
      a += __shfl_xor(a, 32, 64);
      g[n] = (n < qblk) ? a : -INFINITY;
    }
#pragma unroll
    for (int pass = 0; pass < 3; pass++) {
      float best = -INFINITY; int bi = -1;
#pragma unroll
      for (int n = 0; n < 15; n++) {
        bool avail = !((selmask >> n) & 1u);
        if (avail && g[n] > best) { best = g[n]; bi = n; }
      }
      if (bi >= 0) selmask |= (1u << bi);
    }
  }
  {
    unsigned wu = 0;
#pragma unroll
    for (int n = 0; n < 15; n++) { if (__ballot((selmask >> n) & 1u) != 0ull) wu |= (1u << n); }
    if (lane == 0) atomicOr(uni, wu);
  }
  __syncthreads();
  const unsigned ublocks = *uni;
  unsigned wunion = 0;
#pragma unroll
  for (int n = 0; n < 15; n++) { if (__ballot((selmask >> n) & 1u) != 0ull) wunion |= (1u << n); }

  f32x16 o[2];
#pragma unroll
  for (int r = 0; r < 16; r++) { o[0][r] = 0.f; o[1][r] = 0.f; }
  float m_run = -INFINITY, l_run = 0.f;
  const float L2E = 1.4426950408889634f;

  const int own_tiles = (r0 + 128) >> 6;
  int cur_n = -1, cur_j = 0;
  auto advance = [&](int& n, int& j) {
    if (n >= 0 && n <= qblk) {
      int nt = (n == qblk) ? own_tiles : 4;
      if (j + 1 < nt) { j++; return; }
    }
    j = 0;
    int nn = n + 1;
    while (nn < qblk && !((ublocks >> nn) & 1u)) nn++;
    n = nn;
  };
  advance(cur_n, cur_j);
  const int lrow = tid >> 3, lk = (tid & 7) * 8;
  u32x4 rk0, rk1, rv0, rv1;
  auto gload = [&](int n, int j) {
    const u16* kb = ZA + (rowbase + n * 256 + j * 64 + lrow) * ZA_W + 512 + h * 64 + lk;
    rk0 = *(const u32x4*)(kb); rk1 = *(const u32x4*)(kb + (size_t)32 * ZA_W);
    rv0 = *(const u32x4*)(kb + 512); rv1 = *(const u32x4*)(kb + (size_t)32 * ZA_W + 512);
  };
  auto swrite = [&](int st) {
    u16* dk = sm + st * 9216;
    *(u32x4*)(dk + lrow * 72 + lk) = rk0; *(u32x4*)(dk + (lrow + 32) * 72 + lk) = rk1;
    *(u32x4*)(dk + 4608 + lrow * 72 + lk) = rv0; *(u32x4*)(dk + 4608 + (lrow + 32) * 72 + lk) = rv1;
  };
  gload(cur_n, cur_j);
  swrite(0);
  __syncthreads();
  int st = 0;
  while (cur_n <= qblk) {
    int nx_n = cur_n, nx_j = cur_j;
    advance(nx_n, nx_j);
    const bool more = (nx_n <= qblk);
    if (more) gload(nx_n, nx_j);
    const u16* sK = sm + st * 9216;
    const u16* sV = sK + 4608;
    const bool own = (cur_n == qblk);
    bool active = own ? (cur_j * 64 <= r0 + w * 32 + 31) : (((wunion >> cur_n) & 1u) != 0u);
    if (active) {
      f32x16 sc[2];
#pragma unroll
      for (int mt = 0; mt < 2; mt++) {
#pragma unroll
        for (int r = 0; r < 16; r++) sc[mt][r] = 0.f;
#pragma unroll
        for (int s = 0; s < 4; s++) {
          bf16x8 a = *(const bf16x8*)(sK + (mt * 32 + l31) * 72 + 16 * s + 8 * h2);
          sc[mt] = MFMA(a, qf[s], sc[mt]);
        }
      }
      const bool selq = own ? true : (((selmask >> cur_n) & 1u) != 0u);
      const float bias = selq ? 0.f : -INFINITY;
      const int qi = r0 + w * 32 + l31;
      const bool diag = own && (cur_j * 64 + 63 > r0 + w * 32);
      float tmax = -INFINITY;
      if (diag) {
#pragma unroll
        for (int mt = 0; mt < 2; mt++)
#pragma unroll
          for (int r = 0; r < 16; r++) {
            const bool keep = (cur_j * 64 + mt * 32 + crow(r, h2)) <= qi;
            const float v = keep ? sc[mt][r] : -INFINITY;
            sc[mt][r] = v;
            tmax = fmaxf(tmax, v);
          }
      } else {
#pragma unroll
        for (int mt = 0; mt < 2; mt++)
#pragma unroll
          for (int r = 0; r < 16; r++) { const float v = sc[mt][r] + bias; sc[mt][r] = v; tmax = fmaxf(tmax, v); }
      }
      tmax = fmaxf(tmax, __shfl_xor(tmax, 32, 64)) * L2E;
      float m_new = fmaxf(m_run, tmax);
      float m_use = (m_new == -INFINITY) ? 0.f : m_new;
      float alpha = __builtin_amdgcn_exp2f(m_run - m_use);
      m_run = m_new;
      float psum = 0.f;
#pragma unroll
      for (int mt = 0; mt < 2; mt++)
#pragma unroll
        for (int r = 0; r < 16; r++) { float pe = __builtin_amdgcn_exp2f(fmaf(sc[mt][r], L2E, -m_use)); sc[mt][r] = pe; psum += pe; }
      l_run = l_run * alpha + psum;
#pragma unroll
      for (int r = 0; r < 16; r++) { o[0][r] *= alpha; o[1][r] *= alpha; }
      const int q4 = (lane & 15) >> 2, p4 = lane & 3, gsel = (lane >> 4) & 1;
#pragma unroll
      for (int mt = 0; mt < 2; mt++) {
#pragma unroll
        for (int s2 = 0; s2 < 2; s2++) {
          bf16x8 pf = pack8(sc[mt][8 * s2 + 0], sc[mt][8 * s2 + 1], sc[mt][8 * s2 + 2], sc[mt][8 * s2 + 3],
                            sc[mt][8 * s2 + 4], sc[mt][8 * s2 + 5], sc[mt][8 * s2 + 6], sc[mt][8 * s2 + 7]);
          const int key0 = mt * 32 + 16 * s2 + 4 * h2 + q4;
#pragma unroll
          for (int dt = 0; dt < 2; dt++) {
            s16x4 lo = tr_read(sV + key0 * 72 + dt * 32 + 16 * gsel + 4 * p4);
            s16x4 hi = tr_read(sV + (key0 + 8) * 72 + dt * 32 + 16 * gsel + 4 * p4);
            o[dt] = MFMA(cat44(lo, hi), pf, o[dt]);
          }
        }
      }
    }
    if (more) swrite(st ^ 1);
    __syncthreads();
    st ^= 1;
    cur_n = nx_n; cur_j = nx_j;
  }
  float l_tot = l_run + __shfl_xor(l_run, 32, 64);
  float inv = 1.f / l_tot;
  u16* yo = ZA + (rowbase + qrow) * ZA_W + h * 64;
#pragma unroll
  for (int dt = 0; dt < 2; dt++)
#pragma unroll
    for (int g = 0; g < 4; g++) {
      uint2 u = {pack2(o[dt][4 * g] * inv, o[dt][4 * g + 1] * inv), pack2(o[dt][4 * g + 2] * inv, o[dt][4 * g + 3] * inv)};
      *(uint2*)(yo + dt * 32 + 8 * g + 4 * h2) = u;
    }
}

DI void retention_block(const Params& p, int b, int h, char* smem) {
  const int TX = tid_opaque();
  u16* ZB = (u16*)(p.ws + OFF_ZB);
  const int tid = TX, lane = tid & 63, w = tid >> 6, l31 = lane & 31, h2 = lane >> 5;
  const int qt = w & 1, eh = w >> 1;
  u16* sK = (u16*)smem;
  u16* sV = sK + 64 * 136;
  u16* sR = sV + 64 * 136;
  float* exch = (float*)(smem + (64 * 136 * 2 + 128 * 136) * 2);
  const float gamma = 1.0f - exp2f(-5.0f - (float)h);
  const float lg = log2f(gamma);
  const float g64 = exp2f(lg * 64.f);
  __syncthreads();
  for (int i = tid; i < 128 * 136 / 2; i += NTHR) ((unsigned*)sR)[i] = 0u;
  f32x16 racc[4];
#pragma unroll
  for (int dt = 0; dt < 4; dt++)
#pragma unroll
    for (int r = 0; r < 16; r++) racc[dt][r] = 0.f;
  const int q4 = (lane & 15) >> 2, p4 = lane & 3, gsel = (lane >> 4) & 1;
  const int lrow = tid >> 4, lc = (tid & 15) * 8;
  for (int n = 0; n < SEQ / 64; n++) {
    const size_t rb = (size_t)b * SEQ + n * 64;
#pragma unroll
    for (int i = 0; i < 4; i++) {
      int j = lrow + 16 * i;
      const u16* src = ZB + (rb + j) * ZB_W + 512 + h * 128 + lc;
      uint4 kk = *(const uint4*)src;
      uint4 vv = *(const uint4*)(src + 512);
      float z = exp2f(lg * (float)(63 - j));
      uint4 ks = {pack2(bflo(kk.x) * z, bfhi(kk.x) * z), pack2(bflo(kk.y) * z, bfhi(kk.y) * z),
                  pack2(bflo(kk.z) * z, bfhi(kk.z) * z), pack2(bflo(kk.w) * z, bfhi(kk.w) * z)};
      *(uint4*)(sK + j * 136 + lc) = ks;
      *(uint4*)(sV + j * 136 + lc) = vv;
    }
    const int qi = 32 * qt + l31;
    bf16x8 qf[8];
#pragma unroll
    for (int s = 0; s < 8; s++) qf[s] = *(const bf16x8*)(ZB + (rb + qi) * ZB_W + h * 128 + 16 * s + 8 * h2);
    __syncthreads();
    f32x16 acc[2];
#pragma unroll
    for (int et = 0; et < 2; et++) {
#pragma unroll
      for (int r = 0; r < 16; r++) acc[et][r] = 0.f;
#pragma unroll
      for (int s = 0; s < 8; s++) {
        bf16x8 a = *(const bf16x8*)(sR + (32 * (2 * eh + et) + l31) * 136 + 16 * s + 8 * h2);
        acc[et] = MFMA(a, qf[s], acc[et]);
      }
#pragma unroll
      for (int r = 0; r < 16; r++) acc[et][r] *= g64;
    }
    for (int kt = 0; kt <= qt; kt++) {
      f32x16 sc;
#pragma unroll
      for (int r = 0; r < 16; r++) sc[r] = 0.f;
#pragma unroll
      for (int s = 0; s < 8; s++) {
        bf16x8 a = *(const bf16x8*)(sK + (32 * kt + l31) * 136 + 16 * s + 8 * h2);
        sc = MFMA(a, qf[s], sc);
      }
      if (kt == qt) {
#pragma unroll
        for (int r = 0; r < 16; r++) if (crow(r, h2) > l31) sc[r] = 0.f;
      }
#pragma unroll
      for (int s2 = 0; s2 < 2; s2++) {
        bf16x8 pf = pack8(sc[8 * s2 + 0], sc[8 * s2 + 1], sc[8 * s2 + 2], sc[8 * s2 + 3],
                          sc[8 * s2 + 4], sc[8 * s2 + 5], sc[8 * s2 + 6], sc[8 * s2 + 7]);
        const int key0 = 32 * kt + 16 * s2 + 4 * h2 + q4;
#pragma unroll
        for (int et = 0; et < 2; et++) {
          s16x4 lo = tr_read(sV + key0 * 136 + 32 * (2 * eh + et) + 16 * gsel + 4 * p4);
          s16x4 hi = tr_read(sV + (key0 + 8) * 136 + 32 * (2 * eh + et) + 16 * gsel + 4 * p4);
          acc[et] = MFMA(cat44(lo, hi), pf, acc[et]);
        }
      }
    }
    const float fi = exp2f(lg * (float)(qi - 63));
    float s1 = 0.f, s2s = 0.f;
#pragma unroll
    for (int et = 0; et < 2; et++)
#pragma unroll
      for (int r = 0; r < 16; r++) { float y = acc[et][r] * fi; acc[et][r] = y; s1 += y; s2s += y * y; }
    s1 += __shfl_xor(s1, 32, 64); s2s += __shfl_xor(s2s, 32, 64);
    if (h2 == 0) { exch[(w * 32 + l31) * 2] = s1; exch[(w * 32 + l31) * 2 + 1] = s2s; }
    __syncthreads();
    {
      float o1 = exch[((w ^ 2) * 32 + l31) * 2], o2 = exch[((w ^ 2) * 32 + l31) * 2 + 1];
      float mu = (s1 + o1) * (1.0f / 128.0f);
      float var = (s2s + o2) * (1.0f / 128.0f) - mu * mu;
      float rs = rsqrtf(fmaxf(var, 0.f) + 1e-6f);
      u16* rowp = ZB + (rb + qi) * ZB_W;
#pragma unroll
      for (int et = 0; et < 2; et++)
#pragma unroll
        for (int g = 0; g < 4; g++) {
          int e = 32 * (2 * eh + et) + 8 * g + 4 * h2;
          uint2 gg = *(const uint2*)(rowp + 1536 + h * 128 + e);
          float g0 = bflo(gg.x), g1 = bfhi(gg.x), g2 = bflo(gg.y), g3 = bfhi(gg.y);
          float y0 = (acc[et][4 * g] - mu) * rs * g0 * sigmoidf_(g0);
          float y1 = (acc[et][4 * g + 1] - mu) * rs * g1 * sigmoidf_(g1);
          float y2 = (acc[et][4 * g + 2] - mu) * rs * g2 * sigmoidf_(g2);
          float y3 = (acc[et][4 * g + 3] - mu) * rs * g3 * sigmoidf_(g3);
          uint2 u = {pack2(y0, y1), pack2(y2, y3)};
          *(uint2*)(rowp + h * 128 + e) = u;
        }
    }
#pragma unroll
    for (int dt = 0; dt < 4; dt++) {
#pragma unroll
      for (int r = 0; r < 16; r++) racc[dt][r] *= g64;
    }
#pragma unroll
    for (int s = 0; s < 4; s++) {
      const int tk0 = 16 * s + 4 * h2 + q4;
      s16x4 blo = tr_read(sV + tk0 * 136 + 32 * w + 16 * gsel + 4 * p4);
      s16x4 bhi = tr_read(sV + (tk0 + 8) * 136 + 32 * w + 16 * gsel + 4 * p4);
      bf16x8 bfrag = cat44(blo, bhi);
#pragma unroll
      for (int dt = 0; dt < 4; dt++) {
        s16x4 alo = tr_read(sK + tk0 * 136 + 32 * dt + 16 * gsel + 4 * p4);
        s16x4 ahi = tr_read(sK + (tk0 + 8) * 136 + 32 * dt + 16 * gsel + 4 * p4);
        racc[dt] = MFMA(cat44(alo, ahi), bfrag, racc[dt]);
      }
    }
#pragma unroll
    for (int dt = 0; dt < 4; dt++)
#pragma unroll
      for (int g = 0; g < 4; g++) {
        uint2 u = {pack2(racc[dt][4 * g], racc[dt][4 * g + 1]), pack2(racc[dt][4 * g + 2], racc[dt][4 * g + 3])};
        *(uint2*)(sR + (32 * w + l31) * 136 + 32 * dt + 8 * g + 4 * h2) = u;
      }
    __syncthreads();
  }
}

DI void rwkv_epi(const Params& p, int b, int h, int half, int cc, int partner, const unsigned long long* xch,
                 unsigned long long g1, unsigned long long g2, unsigned tag,
                 const float* ybuf, const float* stV, const u16* stG, const float* stS, const float* par, int tid) {
  u16* YC = (u16*)(p.ws + OFF_YC);
  const int ti = tid >> 3, part = tid & 7, slot = cc & 1;
  {
    const unsigned long long* src = xch + ((size_t)(partner * 4 + (cc & 3)) * 32 + ti) * 2;
    unsigned spins = 0;
    while ((unsigned)(g1 >> 32) != tag || (unsigned)(g2 >> 32) != tag) {
      __builtin_amdgcn_s_sleep(1);
      g1 = __hip_atomic_load(src, __ATOMIC_RELAXED, __HIP_MEMORY_SCOPE_AGENT);
      g2 = __hip_atomic_load(src + 1, __ATOMIC_RELAXED, __HIP_MEMORY_SCOPE_AGENT);
      if (++spins > (1u << 22)) break;
    }
  }
  const float o1 = __uint_as_float((unsigned)(g1 & 0xffffffffull)), o2 = __uint_as_float((unsigned)(g2 & 0xffffffffull));
  const float s1 = stS[(slot * 32 + ti) * 4 + 0] + o1, s2 = stS[(slot * 32 + ti) * 4 + 1] + o2;
  const float bonus = stS[(slot * 32 + ti) * 4 + 2];
  const float mean = s1 * (1.f / 64.f);
  const float var = fmaxf(s2 * (1.f / 64.f) - mean * mean, 0.f);
  const float rsd = rsqrtf(var + 64e-5f);
  float o[4];
#pragma unroll
  for (int e = 0; e < 4; e++) {
    const int rr = part * 4 + e, c = half * 32 + rr;
    const float y = (ybuf[slot * 1024 + ti * 32 + rr] - mean) * rsd * par[8 * 64 + c] + par[9 * 64 + c] + bonus * stV[slot * 1024 + ti * 32 + rr];
    o[e] = y * bf2f(stG[slot * 1024 + ti * 32 + rr]);
  }
  uint2 u = {pack2(o[0], o[1]), pack2(o[2], o[3])};
  *(uint2*)(YC + ((size_t)b * SEQ + cc * 32 + ti) * 512 + h * 64 + half * 32 + part * 4) = u;
}

DI void rwkv_block(const Params& p, int l, int b, int h, int half, char* smem) {
  const int TX = tid_opaque();
  const u16* ZC = (const u16*)(p.ws + OFF_ZC);
  u16* YC = (u16*)(p.ws + OFF_YC);
  u16* VF = (u16*)(p.ws + OFF_VF);
  const u16* Wt = (const u16*)(p.ws + OFF_W);
  const int tid = TX, lane = tid & 63, wv = tid >> 6, l31 = lane & 31, h2 = lane >> 5;
  float* opKK = (float*)smem;
  float* opW  = opKK + 2048;
  float* opB  = opW + 2048;
  float* opK  = opB + 2048;
  float* opWR = opK + 2048;
  float* opV  = opWR + 2048;
  u16*   opG  = (u16*)(smem + 49152);
  float* scal = (float*)(smem + 53248);
  float* ybuf = (float*)(smem + 53760);
  float* par  = (float*)(smem + 61952);
  float* stV  = (float*)(smem + 64768);
  u16*   stG  = (u16*)(smem + 72960);
  float* stS  = (float*)(smem + 77056);
  const int me = (b * 8 + h) * 2 + half, partner = me ^ 1;
  unsigned long long* xch = (unsigned long long*)(p.ws + OFF_SM + SM_XCH);
  const u16* ALR = (l == 0) ? (const u16*)p.out : (const u16*)(p.ws + OFF_ACTLR);
  __syncthreads();
  {
    const float* mu = p.in[4] + l * 1792;
    if (tid < 64) {
      const int c = h * 64 + tid;
      par[0 * 64 + tid] = mu[c]; par[1 * 64 + tid] = mu[512 + c]; par[2 * 64 + tid] = mu[1024 + c];
      par[3 * 64 + tid] = p.in[5][l * 512 + c];
      par[4 * 64 + tid] = p.in[7][l * 512 + c];
      par[5 * 64 + tid] = p.in[10][l * 512 + c];
      par[6 * 64 + tid] = p.in[11][l * 512 + c];
      par[7 * 64 + tid] = p.in[12][l * 512 + c];
      par[8 * 64 + tid] = p.in[13][l * 512 + c];
      par[9 * 64 + tid] = p.in[14][l * 512 + c];
      par[10 * 64 + tid] = (l == 1) ? p.in[17][c] : 0.f;
    }
  }
  const int koff = wv * 64;
  const u16* wsrc = Wt + ((wv == 0) ? W_W2 : (wv == 1) ? W_A2 : (wv == 2) ? W_G2 : (W_G2 + 64));
  const int ldw = (wv < 2) ? 64 : 128;
  bf16x8 wf[2][4];
#pragma unroll
  for (int nt = 0; nt < 2; nt++)
#pragma unroll
    for (int s = 0; s < 4; s++) wf[nt][s] = *(const bf16x8*)(wsrc + (size_t)(h * 64 + nt * 32 + l31) * ldw + 16 * s + 8 * h2);
  f2 S[4];
#pragma unroll
  for (int j = 0; j < 4; j++) S[j] = (f2){0.f, 0.f};
  const int kq = lane & 7, rs = lane >> 3;
  const int rloc = wv * 8 + rs, vrow = half * 32 + rloc;
  const int ti = tid >> 3, c0 = (tid & 7) * 8;
  bf16x8 af0, af1, af2, af3, av0, av1;
  u32x4 pr_c, pr_p, pk_c, pk_p, pv_c, pv_p, pvf;
  const u32x4 zero4 = {0u, 0u, 0u, 0u};
  auto issue = [&](int ch) {
    const int s0 = ch * 32;
    const size_t rb = (size_t)b * SEQ + s0;
    {
      const u16* ap = ALR + (rb + l31) * 288 + koff + 8 * h2;
      af0 = *(const bf16x8*)(ap); af1 = *(const bf16x8*)(ap + 16); af2 = *(const bf16x8*)(ap + 32); af3 = *(const bf16x8*)(ap + 48);
      const bf16x8 zz = {0, 0, 0, 0, 0, 0, 0, 0};
      av0 = zz; av1 = zz;
      if (l == 1 && wv == 3) { const u16* vp = ALR + (rb + l31) * 288 + 256 + 8 * h2; av0 = *(const bf16x8*)(vp); av1 = *(const bf16x8*)(vp + 16); }
    }
    const u16* cp = ZC + (rb + ti) * ZC_W + h * 64 + c0;
    pr_c = *(const u32x4*)cp; pk_c = *(const u32x4*)(cp + 512); pv_c = *(const u32x4*)(cp + 1024);
    pr_p = zero4; pk_p = zero4; pv_p = zero4;
    if (s0 + ti > 0) { pr_p = *(const u32x4*)(cp - ZC_W); pk_p = *(const u32x4*)(cp - ZC_W + 512); pv_p = *(const u32x4*)(cp - ZC_W + 1024); }
    pvf = zero4;
    if (l == 1) pvf = *(const u32x4*)(VF + (rb + ti) * 512 + h * 64 + c0);
  };
  issue(0);
  __syncthreads();
  for (int ch = 0; ch < SEQ / 32; ch++) {
    const int s0 = ch * 32;
    const size_t rb = (size_t)b * SEQ + s0;
    const bf16x8 caf0 = af0, caf1 = af1, caf2 = af2, caf3 = af3, cav0 = av0, cav1 = av1;
    float zr[8], zk[8], zv[8], vfv[8];
    {
      float a[8], bb[8];
      unpack8(pr_c, a); unpack8(pr_p, bb);
#pragma unroll
      for (int e = 0; e < 8; e++) zr[e] = a[e] + (bb[e] - a[e]) * par[0 * 64 + c0 + e];
      unpack8(pk_c, a); unpack8(pk_p, bb);
#pragma unroll
      for (int e = 0; e < 8; e++) zk[e] = a[e] + (bb[e] - a[e]) * par[1 * 64 + c0 + e];
      unpack8(pv_c, a); unpack8(pv_p, bb);
#pragma unroll
      for (int e = 0; e < 8; e++) zv[e] = a[e] + (bb[e] - a[e]) * par[2 * 64 + c0 + e];
      unpack8(pvf, vfv);
    }
    {
      f32x16 pa[2];
#pragma unroll
      for (int nt = 0; nt < 2; nt++)
#pragma unroll
        for (int r = 0; r < 16; r++) pa[nt][r] = 0.f;
      pa[0] = MFMA(caf0, wf[0][0], pa[0]); pa[1] = MFMA(caf0, wf[1][0], pa[1]);
      pa[0] = MFMA(caf1, wf[0][1], pa[0]); pa[1] = MFMA(caf1, wf[1][1], pa[1]);
      pa[0] = MFMA(caf2, wf[0][2], pa[0]); pa[1] = MFMA(caf2, wf[1][2], pa[1]);
      pa[0] = MFMA(caf3, wf[0][3], pa[0]); pa[1] = MFMA(caf3, wf[1][3], pa[1]);
      float* dst = (wv == 0) ? opW : (wv == 1) ? opB : (wv == 2) ? opKK : opK;
#pragma unroll
      for (int nt = 0; nt < 2; nt++)
#pragma unroll
        for (int r = 0; r < 16; r++) dst[crow(r, h2) * 64 + nt * 32 + l31] = pa[nt][r];
      if (l == 1 && wv == 3) {
#pragma unroll
        for (int nt = 0; nt < 2; nt++)
#pragma unroll
          for (int r = 0; r < 16; r++) pa[nt][r] = 0.f;
#pragma unroll
        for (int nt = 0; nt < 2; nt++) {
          bf16x8 w0v = *(const bf16x8*)(Wt + W_V2 + (size_t)(h * 64 + nt * 32 + l31) * 32 + 8 * h2);
          bf16x8 w1v = *(const bf16x8*)(Wt + W_V2 + (size_t)(h * 64 + nt * 32 + l31) * 32 + 16 + 8 * h2);
          pa[nt] = MFMA(cav0, w0v, pa[nt]);
          pa[nt] = MFMA(cav1, w1v, pa[nt]);
        }
#pragma unroll
        for (int nt = 0; nt < 2; nt++)
#pragma unroll
          for (int r = 0; r < 16; r++) opV[crow(r, h2) * 64 + nt * 32 + l31] = pa[nt][r];
      }
    }
    lds_barrier();
    {
      typedef float f4 __attribute__((ext_vector_type(4)));
      u32x4 gu;
      float dec[8], av[8];
#define LD8(dst, ptr) do { const f4 t0_ = *(const f4*)(ptr); const f4 t1_ = *(const f4*)((ptr) + 4); \
        dst[0] = t0_[0]; dst[1] = t0_[1]; dst[2] = t0_[2]; dst[3] = t0_[3]; dst[4] = t1_[0]; dst[5] = t1_[1]; dst[6] = t1_[2]; dst[7] = t1_[3]; } while (0)
#define ST8(ptr, src) do { f4 t0_ = {src[0], src[1], src[2], src[3]}; f4 t1_ = {src[4], src[5], src[6], src[7]}; \
        *(f4*)(ptr) = t0_; *(f4*)((ptr) + 4) = t1_; } while (0)
      {
        float g0[8], g1[8], wpre[8], apre[8], pw0[8], pa0[8];
        LD8(g0, opKK + ti * 64 + c0); LD8(g1, opK + ti * 64 + c0);
        LD8(wpre, opW + ti * 64 + c0); LD8(apre, opB + ti * 64 + c0);
        LD8(pw0, par + 3 * 64 + c0); LD8(pa0, par + 4 * 64 + c0);
        gu = (u32x4){pack2(g0[0] + g1[0], g0[1] + g1[1]), pack2(g0[2] + g1[2], g0[3] + g1[3]),
                     pack2(g0[4] + g1[4], g0[5] + g1[5]), pack2(g0[6] + g1[6], g0[7] + g1[7])};
#pragma unroll
        for (int e = 0; e < 8; e++) {
          dec[e] = __expf(-0.6065306597126334f * fsig(wpre[e] + pw0[e]));
          av[e] = fsig(apre[e] + pa0[e]);
        }
      }
      float ssq = 0.f, brs = 0.f, krs = 0.f, bns = 0.f;
      float kkr[8], dwr[8], kpv[8];
      const size_t grow = rb + ti;
      {
        float vgp[8], pkk[8], pka[8], prk[8], pv0[8];
        LD8(vgp, opV + ti * 64 + c0); LD8(pkk, par + 5 * 64 + c0);
        LD8(pka, par + 6 * 64 + c0); LD8(prk, par + 7 * 64 + c0); LD8(pv0, par + 10 * 64 + c0);
#pragma unroll
        for (int e = 0; e < 8; e++) {
          float vv = zv[e];
          if (l == 1) vv = vv + (vfv[e] - vv) * fsig(pv0[e] + vgp[e]);
          zv[e] = vv;
          kkr[e] = zk[e] * pkk[e];
          ssq += kkr[e] * kkr[e];
          const float kp = zk[e] * (1.f + (av[e] - 1.f) * pka[e]);
          dwr[e] = dec[e] * zr[e]; kpv[e] = kp;
          krs += kp * zr[e];
          bns += zr[e] * kp * prk[e];
        }
      }
      ssq = red8(ssq);
      const float inv = (ssq > 1e-24f) ? rsqrtf(ssq) : 1e12f;
      float kkv[8], bvv[8];
#pragma unroll
      for (int e = 0; e < 8; e++) { kkv[e] = kkr[e] * inv; bvv[e] = kkv[e] * av[e]; brs += bvv[e] * zr[e]; }
      brs = red8(brs); krs = red8(krs); bns = red8(bns);
      *(u32x4*)(opG + ti * 64 + c0) = gu;
      ST8(opW + ti * 64 + c0, dec); ST8(opWR + ti * 64 + c0, dwr); ST8(opK + ti * 64 + c0, kpv); ST8(opV + ti * 64 + c0, zv);
      ST8(opKK + ti * 64 + c0, kkv); ST8(opB + ti * 64 + c0, bvv);
      if ((tid & 7) == 0) { scal[ti] = brs; scal[32 + ti] = krs; scal[64 + ti] = bns; }
      if (l == 0 && half == 0) {
        u32x4 u = {pack2(zv[0], zv[1]), pack2(zv[2], zv[3]), pack2(zv[4], zv[5]), pack2(zv[6], zv[7])};
        *(u32x4*)(VF + grow * 512 + h * 64 + c0) = u;
      }
#undef LD8
#undef ST8
    }
    lds_barrier();
    unsigned long long pg1 = 0ull, pg2 = 0ull;
    if (ch >= 1) {
      const unsigned long long* src = xch + ((size_t)(partner * 4 + ((ch - 1) & 3)) * 32 + ti) * 2;
      pg1 = __hip_atomic_load(src, __ATOMIC_RELAXED, __HIP_MEMORY_SCOPE_AGENT);
      pg2 = __hip_atomic_load(src + 1, __ATOMIC_RELAXED, __HIP_MEMORY_SCOPE_AGENT);
    }
    if (ch + 1 < SEQ / 32) issue(ch + 1);
    float* yb = ybuf + (ch & 1) * 1024;
#define SCAN_STEP(T, YOUT) do { \
      const f2* pkk = (const f2*)(opKK + (T) * 64 + 8 * kq); const f2* pw = (const f2*)(opW + (T) * 64 + 8 * kq); \
      const f2* pb = (const f2*)(opB + (T) * 64 + 8 * kq); const f2* pk = (const f2*)(opK + (T) * 64 + 8 * kq); \
      const f2* pwr = (const f2*)(opWR + (T) * 64 + 8 * kq); \
      const float vv = opV[(T) * 64 + vrow]; const float br = scal[(T)], kr = scal[32 + (T)]; \
      f2 kk4[4], w4[4], b4[4], k4[4], wr4[4]; \
      _Pragma("unroll") for (int j = 0; j < 4; j++) { kk4[j] = pkk[j]; w4[j] = pw[j]; b4[j] = pb[j]; k4[j] = pk[j]; wr4[j] = pwr[j]; } \
      const f2 v0v = {vv, vv}; \
      f2 p0 = (S[0] * kk4[0] + S[1] * kk4[1]) + (S[2] * kk4[2] + S[3] * kk4[3]); \
      f2 q0 = (S[0] * wr4[0] + S[1] * wr4[1]) + (S[2] * wr4[2] + S[3] * wr4[3]); \
      f2 tq[4]; \
      _Pragma("unroll") for (int j = 0; j < 4; j++) tq[j] = S[j] * w4[j] + v0v * k4[j];     \
      const float P0 = red8(p0[0] + p0[1]), Q0 = red8(q0[0] + q0[1]); \
      const float sa0 = -P0; const f2 sa0v = {sa0, sa0}; \
      _Pragma("unroll") for (int j = 0; j < 4; j++) S[j] = sa0v * b4[j] + tq[j]; \
      YOUT = Q0 + sa0 * br + vv * kr; } while (0)
#pragma unroll 1
    for (int t = 0; t < 32; t += 4) {
      float y0_, y1_, y2_, y3_;
      SCAN_STEP(t, y0_);
      SCAN_STEP(t + 1, y1_);
      SCAN_STEP(t + 2, y2_);
      SCAN_STEP(t + 3, y3_);
      if (kq == 0) { yb[t * 32 + rloc] = y0_; yb[(t + 1) * 32 + rloc] = y1_; yb[(t + 2) * 32 + rloc] = y2_; yb[(t + 3) * 32 + rloc] = y3_; }
    }
#undef SCAN_STEP
    lds_barrier();
    {
      const int part = tid & 7, slot = ch & 1;
      float s1 = 0.f, s2 = 0.f;
      float yv_[4], vv_[4]; u16 gg_[4];
#pragma unroll
      for (int e = 0; e < 4; e++) {
        const int rr = part * 4 + e;
        yv_[e] = yb[ti * 32 + rr]; vv_[e] = opV[ti * 64 + half * 32 + rr]; gg_[e] = opG[ti * 64 + half * 32 + rr];
      }
      const float bon_ = scal[64 + ti];
#pragma unroll
      for (int e = 0; e < 4; e++) {
        const int rr = part * 4 + e;
        s1 += yv_[e]; s2 += yv_[e] * yv_[e];
        stV[slot * 1024 + ti * 32 + rr] = vv_[e];
        stG[slot * 1024 + ti * 32 + rr] = gg_[e];
      }
      s1 = red8(s1); s2 = red8(s2);
      if (part == 0) {
        stS[(slot * 32 + ti) * 4 + 0] = s1; stS[(slot * 32 + ti) * 4 + 1] = s2; stS[(slot * 32 + ti) * 4 + 2] = bon_;
        const unsigned long long tg = (unsigned long long)(unsigned)(ch + 1) << 32;
        unsigned long long* dst = xch + ((size_t)(me * 4 + (ch & 3)) * 32 + ti) * 2;
        __hip_atomic_store(dst, tg | (unsigned long long)__float_as_uint(s1), __ATOMIC_RELAXED, __HIP_MEMORY_SCOPE_AGENT);
        __hip_atomic_store(dst + 1, tg | (unsigned long long)__float_as_uint(s2), __ATOMIC_RELAXED, __HIP_MEMORY_SCOPE_AGENT);
      }
    }
    lds_barrier();
    if (ch >= 1) rwkv_epi(p, b, h, half, ch - 1, partner, xch, pg1, pg2, (unsigned)ch, ybuf, stV, stG, stS, par, tid);
  }
  lds_barrier();
  rwkv_epi(p, b, h, half, SEQ / 32 - 1, partner, xch, 0ull, 0ull, (unsigned)(SEQ / 32), ybuf, stV, stG, stS, par, tid);
  lds_barrier();
}

DI void phase_mixers(const Params& p, int l, char* smem) {
  const int TX = tid_opaque();
  const int bid = blockIdx.x;
  int* cnt = (int*)(p.ws + OFF_SM + SM_CNT);
  __shared__ int s_item;
  if (EN_RWKV && bid < 128) { rwkv_block(p, l, bid >> 4, (bid >> 1) & 7, bid & 1, smem); }
  else if (EN_RET && bid >= 128 && bid < 160) { int i = bid - 128; retention_block(p, i >> 2, i & 3, smem); }
  if (!EN_ATT) return;
  for (;;) {
    __syncthreads();
    if (TX == 0) s_item = atomicAdd(cnt, 1);
    __syncthreads();
    int it = s_item;
    if (it >= 2048) break;
    int qt = 31 - (it >> 6), bh = it & 63;
    attn_item(p, bh >> 3, bh & 7, qt, smem);
  }
}

DI void phase_merge(const Params& p, char* smem) {
  const int TX = tid_opaque();
  const u16* XB = (const u16*)(p.ws + OFF_XB);
  const u16* W = (const u16*)(p.ws + OFF_W);
  const float* rstd = (const float*)(p.ws + OFF_SM + SM_RSTD);
  u16* MG = (u16*)(p.ws + OFF_MERGED);
  const int lane = TX & 63, w = TX >> 6, wr = w >> 1, wc = w & 1, l31 = lane & 31, h2 = lane >> 5;
  const int ntiles = 256 * 8;
  u16* T = (u16*)smem;
  for (int t = blockIdx.x; t < ntiles; t += gridDim.x) {
    int m0, n0; tile_coords(t, 8, m0, n0);
    bool first = true;
#pragma unroll 1
    for (int n = 0; n < 3; n++) {
      bool en = (n == 0) ? (EN_ATT != 0) : (n == 1) ? (EN_RET != 0) : (EN_RWKV != 0);
      if (!en) continue;
      f32x16 acc[2][2]; zero_acc<2>(acc);
      gemm_tile<2>(XB, 1024, W + W_G + (size_t)n * 1024 * 1024, 1024, 1024, m0, n0, acc, smem);
      unsigned gtp[2][2][8];
      {
        float rs[2][16];
#pragma unroll
        for (int mi = 0; mi < 2; mi++)
#pragma unroll
          for (int r = 0; r < 16; r++) rs[mi][r] = rstd[m0 + wr * 64 + mi * 32 + crow(r, h2)];
#pragma unroll
        for (int mi = 0; mi < 2; mi++)
#pragma unroll
          for (int ni = 0; ni < 2; ni++)
#pragma unroll
            for (int q = 0; q < 8; q++)
              gtp[mi][ni][q] = pack2(fsig(acc[mi][ni][2 * q] * rs[mi][2 * q]), fsig(acc[mi][ni][2 * q + 1] * rs[mi][2 * q + 1]));
      }
      zero_acc<2>(acc);
      const u16* Y; int ldy;
      if (n == 0) { Y = (const u16*)(p.ws + OFF_ZA); ldy = ZA_W; }
      else if (n == 1) { Y = (const u16*)(p.ws + OFF_ZB); ldy = ZB_W; }
      else { Y = (const u16*)(p.ws + OFF_YC); ldy = 512; }
      gemm_tile<2>(Y, ldy, W + W_BR + (size_t)n * 1024 * 512, 512, 512, m0, n0, acc, smem);
#pragma unroll
      for (int mi = 0; mi < 2; mi++)
#pragma unroll
        for (int ni = 0; ni < 2; ni++)
#pragma unroll
          for (int r = 0; r < 16; r++) {
            const unsigned g = gtp[mi][ni][r >> 1];
            const float gv = (r & 1) ? bfhi(g) : bflo(g);
            T[(wr * 64 + mi * 32 + crow(r, h2)) * 136 + wc * 64 + ni * 32 + l31] = f2bf(gv * acc[mi][ni][r]);
          }
      __syncthreads();
      {
#pragma unroll 1
        for (int hh = 0; hh < 2; hh++) {
          u32x4 tv[4], ov[4];
#pragma unroll
          for (int i = 0; i < 4; i++) {
            const int idx = TX + 256 * (hh * 4 + i), row = idx >> 4, chn = idx & 15;
            tv[i] = *(const u32x4*)(T + row * 136 + chn * 8);
            ov[i] = (u32x4){0u, 0u, 0u, 0u};
            if (!first) ov[i] = *(const u32x4*)(MG + (size_t)(m0 + row) * 1024 + n0 + chn * 8);
          }
#pragma unroll
          for (int i = 0; i < 4; i++) {
            const int idx = TX + 256 * (hh * 4 + i), row = idx >> 4, chn = idx & 15;
            u32x4 o;
#pragma unroll
            for (int q = 0; q < 4; q++) o[q] = pack2(bflo(tv[i][q]) + bflo(ov[i][q]), bfhi(tv[i][q]) + bfhi(ov[i][q]));
            *(u32x4*)(MG + (size_t)(m0 + row) * 1024 + n0 + chn * 8) = o;
          }
        }
      }
      first = false;
    }
  }
}

DI void phase_resid(const Params& p, const u16* A, int lda, const u16* Bt, int K, const float* xin, float* xout, char* smem) {
  const int TX = tid_opaque();
  const int lane = TX & 63, w = TX >> 6, wr = w >> 1, wc = w & 1, l31 = lane & 31, h2 = lane >> 5;
  const int ntiles = 256 * 8;
  for (int t = blockIdx.x; t < ntiles; t += gridDim.x) {
    int m0, n0; tile_coords(t, 8, m0, n0);
    f32x16 acc[2][2]; zero_acc<2>(acc);
    gemm_tile<2>(A, lda, Bt, K, K, m0, n0, acc, smem);
    float xv[2][2][16];
#pragma unroll
    for (int mi = 0; mi < 2; mi++)
#pragma unroll
      for (int ni = 0; ni < 2; ni++)
#pragma unroll
        for (int r = 0; r < 16; r++) xv[mi][ni][r] = xin[(size_t)(m0 + wr * 64 + mi * 32 + crow(r, h2)) * 1024 + n0 + wc * 64 + ni * 32 + l31];
#pragma unroll
    for (int mi = 0; mi < 2; mi++)
#pragma unroll
      for (int ni = 0; ni < 2; ni++)
#pragma unroll
        for (int r = 0; r < 16; r++) xout[(size_t)(m0 + wr * 64 + mi * 32 + crow(r, h2)) * 1024 + n0 + wc * 64 + ni * 32 + l31] = xv[mi][ni][r] + acc[mi][ni][r];
  }
}

DI void phase_gateup(const Params& p, char* smem) {
  const int TX = tid_opaque();
  const u16* XB = (const u16*)(p.ws + OFF_XB);
  const u16* W = (const u16*)(p.ws + OFF_W) + W_GU;
  const float* rstd = (const float*)(p.ws + OFF_SM + SM_RSTD);
  u16* ACT = (u16*)(p.ws + OFF_ACT);
  const int lane = TX & 63, w = TX >> 6, wr = w >> 1, wc = w & 1, l31 = lane & 31, h2 = lane >> 5;
  const int ntiles = 256 * 44;
  u32x4 pa[2][4], pb[2][4];
  int t = blockIdx.x, m0 = 0, n0 = 0;
  if (t < ntiles) { tile_coords(t, 44, m0, n0); gemm_pref<2>(XB, 1024, W, 1024, m0, n0, pa, pb); }
  for (; t < ntiles; t += gridDim.x) {
    f32x16 acc[2][2]; zero_acc<2>(acc);
    gemm_main<2>(XB, 1024, W, 1024, 1024, m0, n0, acc, smem, pa, pb);
    const int em0 = m0, en0 = n0;
    float rs[2][16];
#pragma unroll
    for (int mi = 0; mi < 2; mi++)
#pragma unroll
      for (int r = 0; r < 16; r++) rs[mi][r] = rstd[em0 + wr * 64 + mi * 32 + crow(r, h2)];
    if (t + (int)gridDim.x < ntiles) { tile_coords(t + gridDim.x, 44, m0, n0); gemm_pref<2>(XB, 1024, W, 1024, m0, n0, pa, pb); }
    u16* T = (u16*)smem;
#pragma unroll
    for (int mi = 0; mi < 2; mi++)
#pragma unroll
      for (int r = 0; r < 16; r++) {
        const float g = acc[mi][0][r] * rs[mi][r], u = acc[mi][1][r] * rs[mi][r];
        T[(wr * 64 + mi * 32 + crow(r, h2)) * 72 + wc * 32 + l31] = f2bf(g * fsig(g) * u);
      }
    __syncthreads();
    {
      u16* dst = ACT + (size_t)em0 * DFF + (en0 >> 7) * 64;
      u32x4 tv[4];
#pragma unroll
      for (int i = 0; i < 4; i++) { const int idx = TX + 256 * i; tv[i] = *(const u32x4*)(T + (idx >> 3) * 72 + (idx & 7) * 8); }
#pragma unroll
      for (int i = 0; i < 4; i++) { const int idx = TX + 256 * i; *(u32x4*)(dst + (size_t)(idx >> 3) * DFF + (idx & 7) * 8) = tv[i]; }
    }
  }
}

DI void phase_ple(const Params& p, char* smem) {
  const int TX = tid_opaque();
  const u16* XB = (const u16*)(p.ws + OFF_XB);
  const u16* PB = (const u16*)(p.ws + OFF_PB);
  const u16* W = (const u16*)(p.ws + OFF_W);
  const float* rstd = (const float*)(p.ws + OFF_SM + SM_RSTD);
  const int lane = TX & 63, w = TX >> 6, wr = w >> 1, wc = w & 1, l31 = lane & 31, h2 = lane >> 5;
  const int ntiles = 256 * 8;
  for (int t = blockIdx.x; t < ntiles; t += gridDim.x) {
    int m0, n0; tile_coords(t, 8, m0, n0);
    f32x16 acc[2][2]; zero_acc<2>(acc);
    gemm_tile<2>(PB, 256, W + W_PP, 256, 256, m0, n0, acc, smem);
    unsigned pp[2][2][8];
#pragma unroll
    for (int mi = 0; mi < 2; mi++)
#pragma unroll
      for (int ni = 0; ni < 2; ni++)
#pragma unroll
        for (int q = 0; q < 8; q++) pp[mi][ni][q] = pack2(acc[mi][ni][2 * q], acc[mi][ni][2 * q + 1]);
    zero_acc<2>(acc);
    gemm_tile<2>(XB, 1024, W + W_PG, 1024, 1024, m0, n0, acc, smem);
#pragma unroll
    for (int mi = 0; mi < 2; mi++) {
      float rs[16], xv[2][16];
#pragma unroll
      for (int r = 0; r < 16; r++) rs[r] = rstd[m0 + wr * 64 + mi * 32 + crow(r, h2)];
#pragma unroll
      for (int ni = 0; ni < 2; ni++)
#pragma unroll
        for (int r = 0; r < 16; r++) xv[ni][r] = p.out[(size_t)(m0 + wr * 64 + mi * 32 + crow(r, h2)) * 1024 + n0 + wc * 64 + ni * 32 + l31];
#pragma unroll
      for (int ni = 0; ni < 2; ni++)
#pragma unroll
        for (int r = 0; r < 16; r++) {
          const unsigned pu = pp[mi][ni][r >> 1];
          const float pv = (r & 1) ? bfhi(pu) : bflo(pu);
          p.out[(size_t)(m0 + wr * 64 + mi * 32 + crow(r, h2)) * 1024 + n0 + wc * 64 + ni * 32 + l31] = xv[ni][r] + pv * fsig(acc[mi][ni][r] * rs[r]);
        }
    }
  }
}

#define XB_TMO      128
#define XB_XCNT(j)  (256  + 64 * (j))
#define XB_XSUB(j)  (1280 + 64 * (j))
#define XB_XGEN(j)  (2304 + 64 * (j))
#define XB_TOP      3328
#define XB_TOPGEN   3392
#define XCD_BAR_WORDS 3456
#define XB_SPIN_CAP (1u << 18)
#define LAS __attribute__((address_space(3)))

__device__ __forceinline__ unsigned xb_ld(unsigned* p)              { return __hip_atomic_load(p, __ATOMIC_RELAXED, __HIP_MEMORY_SCOPE_AGENT); }
__device__ __forceinline__ unsigned xb_add(unsigned* p, unsigned v) { return __hip_atomic_fetch_add(p, v, __ATOMIC_RELAXED, __HIP_MEMORY_SCOPE_AGENT); }
__device__ __forceinline__ unsigned xb_xcc_id() { return (unsigned)__builtin_amdgcn_s_getreg((3 << 11) | 20) & 0xFu; }
#define XB_SPIN(cond, bar) do { unsigned _sp = 0; while (cond) { __builtin_amdgcn_s_sleep(1); \
    if ((++_sp & 255u) == 0u) { if (xb_ld(&(bar)[XB_TMO])) break; if (_sp > XB_SPIN_CAP) { atomicAdd(&(bar)[XB_TMO], 1u); break; } } } } while (0)

struct XcdBarrier {
    unsigned* bar; unsigned x;
    volatile LAS unsigned* st;
};

__device__ __forceinline__ XcdBarrier xcd_barrier_post(unsigned* bar, volatile LAS unsigned* st) {
    XcdBarrier b; b.bar = bar; b.x = xb_xcc_id(); b.st = st;
    if (threadIdx.x == 0) (void)xb_add(&bar[XB_XCNT(b.x)], 1u);
    return b;
}
__device__ __forceinline__ void xcd_barrier_complete(unsigned* bar, unsigned x, unsigned& nloc, unsigned& nx) {
    const unsigned G = gridDim.x * gridDim.y * gridDim.z;
    unsigned sum, cnt, mine, sp = 0u;
    for (;;) {
        sum = 0u; cnt = 0u; mine = 0u;
#pragma unroll
        for (unsigned j = 0; j < 16; ++j) { const unsigned c = xb_ld(&bar[XB_XCNT(j)]); sum += c; cnt += (c > 0u) ? 1u : 0u; mine = (j == x) ? c : mine; }
        if (sum == G) break;
        __builtin_amdgcn_s_sleep(1);
        if ((++sp & 255u) == 0u) { if (xb_ld(&bar[XB_TMO])) break; if (sp > XB_SPIN_CAP) { atomicAdd(&bar[XB_TMO], 1u); break; } }
    }
    nloc = mine > 0u ? mine : 1u; nx = cnt > 0u ? cnt : 1u;
}

__device__ __forceinline__ void xcd_barrier(const XcdBarrier& b) {
    asm volatile("s_waitcnt vmcnt(0)" ::: "memory");
    __syncthreads();
    if (threadIdx.x == 0) {
        unsigned* bar = b.bar;
        __builtin_amdgcn_s_waitcnt(0);
        unsigned nloc = b.st[0], nx = b.st[1];
        if (nloc == 0u) { xcd_barrier_complete(bar, b.x, nloc, nx); b.st[0] = nloc; b.st[1] = nx; }
        const unsigned old = xb_add(&bar[XB_XSUB(b.x)], 1u);
        const unsigned gen = old / nloc;
        if (old + 1u == (gen + 1u) * nloc) {
            __builtin_amdgcn_fence(__ATOMIC_RELEASE, "agent");
            asm volatile("s_waitcnt vmcnt(0)" ::: "memory");
            const unsigned og = xb_add(&bar[XB_TOP], 1u);
            const unsigned tg = og / nx;
            if (og + 1u == (tg + 1u) * nx) xb_add(&bar[XB_TOPGEN], 1u);
            else XB_SPIN(xb_ld(&bar[XB_TOPGEN]) == tg, bar);
            __builtin_amdgcn_fence(__ATOMIC_ACQUIRE, "agent");
            xb_add(&bar[XB_XGEN(b.x)], 1u);
            asm volatile("s_waitcnt vmcnt(0)" ::: "memory");
        } else {
            XB_SPIN(xb_ld(&bar[XB_XGEN(b.x)]) == gen, bar);
            __builtin_amdgcn_fence(__ATOMIC_ACQUIRE, "agent");
            asm volatile("s_waitcnt vmcnt(0)" ::: "memory");
        }
    }
    __syncthreads();
}

template <int L>
DI void run_layer(const Params& p, char* smem, cg::grid_group& grid, const XcdBarrier& xb) {
  const float* xin = (L == 0) ? p.in[0] : p.out;
  phase_convw(p, L);
  phase_prep(p, xin, nullptr);
  if (L == 0) { grid.sync(); if (threadIdx.x == 0) (void)xb_add(&xb.bar[XB_XCNT(xb.x)], 1u); }
  else xcd_barrier(xb);
  phase_inproj(p, L, smem);
  xcd_barrier(xb);
  phase_kmean(p, smem);
  phase_lrprep(p, L);
  xcd_barrier(xb);
  phase_mixers(p, L, smem);
  xcd_barrier(xb);
  if (L == 1) { phase_prep(p, xin, nullptr); xcd_barrier(xb); }
  phase_merge(p, smem);
  xcd_barrier(xb);
  phase_resid(p, (const u16*)(p.ws + OFF_MERGED), 1024, (const u16*)(p.ws + OFF_W) + W_OUT, 1024, xin, p.out, smem);
  xcd_barrier(xb);
  phase_prep(p, p.out, nullptr);
  xcd_barrier(xb);
  phase_gateup(p, smem);
  xcd_barrier(xb);
  phase_resid(p, (const u16*)(p.ws + OFF_ACT), DFF, (const u16*)(p.ws + OFF_W) + W_DN, DFF, p.out, p.out, smem);
  xcd_barrier(xb);
  phase_prep(p, p.out, p.in[1] + (size_t)L * T_TOK * 256);
  xcd_barrier(xb);
  phase_ple(p, smem);
  xcd_barrier(xb);
}

__global__ void __launch_bounds__(NTHR, 2) fwd_megakernel(Params p) {
  cg::grid_group grid = cg::this_grid();
  __shared__ __attribute__((aligned(16))) char smem[SMEM_BYTES];
  __shared__ uint4 xb_words;
  if (threadIdx.x == 0) xb_words = make_uint4(0u, 0u, 0u, 0u);
  __syncthreads();
  XcdBarrier xb; xb.bar = (unsigned*)(p.ws + OFF_SM + SM_BAR); xb.x = xb_xcc_id(); xb.st = (volatile LAS unsigned*)&xb_words;
  if (blockIdx.x == 0) for (int i = threadIdx.x; i < XCD_BAR_WORDS; i += NTHR) xb.bar[i] = 0u;
  run_layer<0>(p, smem, grid, xb);
  run_layer<1>(p, smem, grid, xb);
  phase_final(p);
}

extern "C" void kernel_launch(void* const* d_in, const int* in_sizes, int n_in, void* d_out, int out_size,
                              void* d_ws, size_t ws_size, hipStream_t stream) {
  static int grid_blocks = 0;
  if (!grid_blocks) {
    int dev = 0, cus = 0, per_cu = 0;
    (void)hipGetDevice(&dev);
    (void)hipDeviceGetAttribute(&cus, hipDeviceAttributeMultiprocessorCount, dev);
    (void)hipOccupancyMaxActiveBlocksPerMultiprocessor(&per_cu, fwd_megakernel, NTHR, 0);
    if (per_cu > 2) per_cu = 2;
    if (per_cu < 1) per_cu = 1;
    grid_blocks = cus * per_cu;
  }
  Params p{};
  for (int i = 0; i < 28; i++) p.in[i] = (const float*)d_in[i];
  p.out = (float*)d_out;
  p.ws = (char*)d_ws;
  void* args[] = {&p};
  hipError_t e = hipLaunchCooperativeKernel((void*)fwd_megakernel, dim3(grid_blocks), dim3(NTHR), args, 0, stream);
  if (e != hipSuccess) fprintf(stderr, "cooperative launch failed: %s (grid %d)\n", hipGetErrorString(e), grid_blocks);
}
```

```cpp
#include <hip/hip_runtime.h>
#include <hip/hip_cooperative_groups.h>
#include <cstdio>
#include <cstdint>
namespace cg = cooperative_groups;

#ifndef EN_ATT
#define EN_ATT 1
#endif
#ifndef EN_RET
#define EN_RET 1
#endif
#ifndef EN_RWKV
#define EN_RWKV 1
#endif

typedef unsigned short u16;
using bf16x8 = __attribute__((ext_vector_type(8))) short;
using s16x4  = __attribute__((ext_vector_type(4))) short;
using f32x16 = __attribute__((ext_vector_type(16))) float;
typedef float f2 __attribute__((ext_vector_type(2)));
typedef unsigned u32x4 __attribute__((ext_vector_type(4)));
typedef __bf16 bf2 __attribute__((ext_vector_type(2)));
#define DI __device__ __forceinline__
#define MFMA(a, b, c) __builtin_amdgcn_mfma_f32_32x32x16_bf16((a), (b), (c), 0, 0, 0)

constexpr int T_TOK = 32768, SEQ = 4096, DM = 1024, NBATCH = 8;
constexpr int DFF = 2816;
constexpr int ZA_W = 1536, ZB_W = 2048, ZC_W = 1824;
constexpr int N_INP = 5376;
constexpr int N_INP_PAD = 5504;
constexpr int SMEM_BYTES = 79872;
constexpr int NTHR = 256;

constexpr size_t MiB = 1048576ull;
constexpr size_t OFF_XB = 0;
constexpr size_t OFF_ZA = OFF_XB + 64 * MiB;
constexpr size_t OFF_ZB = OFF_ZA + 96 * MiB;
constexpr size_t OFF_ZC = OFF_ZB + 128 * MiB;
constexpr size_t OFF_YC = OFF_ZC + 114 * MiB;
constexpr size_t OFF_VF = OFF_YC + 32 * MiB;
constexpr size_t OFF_W  = OFF_VF + 32 * MiB;
constexpr size_t OFF_SM = OFF_W + 42 * MiB;
constexpr size_t OFF_MERGED = OFF_ZC;
constexpr size_t OFF_PB     = OFF_ZC + 64 * MiB;
constexpr size_t OFF_ACT    = OFF_ZA;
constexpr size_t OFF_ACTLR  = OFF_XB;
constexpr size_t W_IN  = 0;
constexpr size_t W_G   = W_IN + (size_t)N_INP_PAD * 1024;
constexpr size_t W_BR  = W_G + 3072ull * 1024;
constexpr size_t W_OUT = W_BR + 3ull * 1024 * 512;
constexpr size_t W_GU  = W_OUT + 1024ull * 1024;
constexpr size_t W_DN  = W_GU + 5632ull * 1024;
constexpr size_t W_PG  = W_DN + 1024ull * 2816;
constexpr size_t W_PP  = W_PG + 1024ull * 1024;
constexpr size_t W_W2  = W_PP + 1024ull * 256;
constexpr size_t W_A2  = W_W2 + 512ull * 64;
constexpr size_t W_G2  = W_A2 + 512ull * 64;
constexpr size_t W_V2  = W_G2 + 512ull * 128;
constexpr size_t W_END = W_V2 + 512ull * 32;
static_assert(W_END * 2 <= 42 * MiB, "weights region");
constexpr size_t SM_RSTD = 0;
constexpr size_t SM_KMEAN = SM_RSTD + 4ull * T_TOK;
constexpr size_t SM_COSA = SM_KMEAN + 4ull * 8 * 16 * 8 * 64;
constexpr size_t SM_SINA = SM_COSA + 4ull * 4096 * 8;
constexpr size_t SM_COSB = SM_SINA + 4ull * 4096 * 8;
constexpr size_t SM_SINB = SM_COSB + 4ull * 4096 * 64;
constexpr size_t SM_CNT  = SM_SINB + 4ull * 4096 * 64;
constexpr size_t SM_BAR  = SM_CNT + 256;
constexpr size_t SM_FLG  = SM_BAR + 4 * 3456;
constexpr size_t SM_XCH  = SM_FLG + 128 * 64;
constexpr size_t SM_END  = SM_XCH + 128 * 4 * 32 * 2 * 8;
static_assert(OFF_SM + SM_END <= 512 * MiB, "ws budget");

struct Params {
  const float* in[28];
  float* out;
  char* ws;
};

DI u16 f2bf(float x) { unsigned u = __float_as_uint(x); u += 0x7fffu + ((u >> 16) & 1u); return (u16)(u >> 16); }
DI float bf2f(u16 v) { return __uint_as_float(((unsigned)v) << 16); }
DI unsigned pack2(float a, float b) { f2 v = {a, b}; bf2 r = __builtin_convertvector(v, bf2); return __builtin_bit_cast(unsigned, r); }
DI float bflo(unsigned u) { return __uint_as_float(u << 16); }
DI float bfhi(unsigned u) { return __uint_as_float(u & 0xffff0000u); }
DI int tid_opaque() { int t = threadIdx.x; asm volatile("" : "+v"(t)); return t; }
DI void lds_barrier() { asm volatile("s_waitcnt lgkmcnt(0)\n\ts_barrier" ::: "memory"); }
DI int crow(int reg, int h) { return (reg & 3) + 8 * (reg >> 2) + 4 * h; }
DI float sigmoidf_(float x) { return 1.f / (1.f + __expf(-x)); }
template <int CTRL> DI float dpp_mov(float v) {
  return __builtin_bit_cast(float, __builtin_amdgcn_update_dpp(0, __builtin_bit_cast(int, v), CTRL, 0xF, 0xF, true));
}
DI float red8(float v) {
  v += dpp_mov<0xB1>(v); v += dpp_mov<0x4E>(v); v += dpp_mov<0x141>(v); return v;
}
DI bf16x8 pack8(float a0, float a1, float a2, float a3, float a4, float a5, float a6, float a7) {
  uint4 u = {pack2(a0, a1), pack2(a2, a3), pack2(a4, a5), pack2(a6, a7)};
  return __builtin_bit_cast(bf16x8, u);
}
DI s16x4 tr_read(const u16* p) {
  return __builtin_amdgcn_ds_read_tr16_b64_v4i16((__attribute__((address_space(3))) s16x4*)(p));
}
DI float fast_rcp(float x) { return __builtin_amdgcn_rcpf(x); }
DI float fsig(float x) { return fast_rcp(1.f + __expf(-x)); }
DI float ftanh(float x) { return 1.f - 2.f * fast_rcp(1.f + __expf(2.f * x)); }
DI void unpack8(u32x4 u, float (&o)[8]) {
  o[0] = bflo(u[0]); o[1] = bfhi(u[0]); o[2] = bflo(u[1]); o[3] = bfhi(u[1]);
  o[4] = bflo(u[2]); o[5] = bfhi(u[2]); o[6] = bflo(u[3]); o[7] = bfhi(u[3]);
}
DI bf16x8 cat44(s16x4 lo, s16x4 hi) { return __builtin_shufflevector(lo, hi, 0, 1, 2, 3, 4, 5, 6, 7); }
template <int MI>
DI void zero_acc(f32x16 (&acc)[MI][2]) {
#pragma unroll
  for (int i = 0; i < MI; i++)
#pragma unroll
    for (int j = 0; j < 2; j++)
#pragma unroll
      for (int r = 0; r < 16; r++) acc[i][j][r] = 0.f;
}

#define LDS_PTR(p) ((__attribute__((address_space(3))) void*)(p))
#define GLB_PTR(p) ((const __attribute__((address_space(1))) void*)(p))
template <int MI>
DI void gemm_pref(const u16* __restrict__ A, int lda, const u16* __restrict__ Bt, int ldb, int m0, int n0,
                  u32x4 (&pa)[2][4], u32x4 (&pb)[2][4]) {
  const int tid = tid_opaque();
  const int lrow = tid >> 3, lk = (tid & 7) * 8;
  const u16* ag = A + (size_t)(m0 + lrow) * lda + lk;
  const u16* bg = Bt + (size_t)(n0 + lrow) * ldb + lk;
#pragma unroll
  for (int st = 0; st < 2; st++) {
#pragma unroll
    for (int i = 0; i < 2 * MI; i++) pa[st][i] = *(const u32x4*)(ag + (size_t)st * 64 + (size_t)(32 * i) * lda);
#pragma unroll
    for (int i = 0; i < 4; i++) pb[st][i] = *(const u32x4*)(bg + (size_t)st * 64 + (size_t)(32 * i) * ldb);
  }
}
template <int MI>
DI void gemm_main(const u16* __restrict__ A, int lda, const u16* __restrict__ Bt, int ldb, int K,
                  int m0, int n0, f32x16 (&acc)[MI][2], char* smem, u32x4 (&pa)[2][4], u32x4 (&pb)[2][4]) {
  const int TX = tid_opaque();
  const int tid = TX, lane = tid & 63, w = tid >> 6, wr = w >> 1, wc = w & 1;
  const int l31 = lane & 31, h2 = lane >> 5;
  const int lrow = tid >> 3, lk = (tid & 7) * 8;
  const u16* ag = A + (size_t)(m0 + lrow) * lda + lk;
  const u16* bg = Bt + (size_t)(n0 + lrow) * ldb + lk;
  u16* sm = (u16*)smem;
#define G_LOAD(S, KT) do { const u16* a_ = ag + (size_t)(KT) * 64; const u16* b_ = bg + (size_t)(KT) * 64; \
    _Pragma("unroll") for (int i_ = 0; i_ < 2 * MI; i_++) pa[S][i_] = *(const u32x4*)(a_ + (size_t)(32 * i_) * lda); \
    _Pragma("unroll") for (int i_ = 0; i_ < 4; i_++) pb[S][i_] = *(const u32x4*)(b_ + (size_t)(32 * i_) * ldb); } while (0)
#define S_WRITE(S, BUF) do { u16* d_ = sm + (BUF) * 18432; \
    _Pragma("unroll") for (int i_ = 0; i_ < 2 * MI; i_++) *(u32x4*)(d_ + (lrow + 32 * i_) * 72 + lk) = pa[S][i_]; \
    _Pragma("unroll") for (int i_ = 0; i_ < 4; i_++) *(u32x4*)(d_ + 9216 + (lrow + 32 * i_) * 72 + lk) = pb[S][i_]; } while (0)
#define LDFRAG(KS, FA, FB0, FB1) do { \
      FB0 = *(const bf16x8*)(sB_ + (wc * 64 + l31) * 72 + (KS) * 16 + h2 * 8); \
      FB1 = *(const bf16x8*)(sB_ + (wc * 64 + 32 + l31) * 72 + (KS) * 16 + h2 * 8); \
      _Pragma("unroll") for (int mi = 0; mi < MI; mi++) FA[mi] = *(const bf16x8*)(sA_ + (wr * 32 * MI + mi * 32 + l31) * 72 + (KS) * 16 + h2 * 8); } while (0)
#define DOMMA(FA, FB0, FB1) do { _Pragma("unroll") for (int mi = 0; mi < MI; mi++) { \
      acc[mi][0] = MFMA(FA[mi], FB0, acc[mi][0]); acc[mi][1] = MFMA(FA[mi], FB1, acc[mi][1]); } } while (0)
#define COMPUTE(BUF) do { const u16* sA_ = sm + (BUF) * 18432; const u16* sB_ = sA_ + 9216; \
    bf16x8 fa0[MI], fa1[MI], fb00, fb01, fb10, fb11; \
    LDFRAG(0, fa0, fb00, fb01); \
    LDFRAG(1, fa1, fb10, fb11); \
    DOMMA(fa0, fb00, fb01); \
    LDFRAG(2, fa0, fb00, fb01); \
    DOMMA(fa1, fb10, fb11); \
    LDFRAG(3, fa1, fb10, fb11); \
    DOMMA(fa0, fb00, fb01); \
    DOMMA(fa1, fb10, fb11); } while (0)
  const int nk = K >> 6;
  __syncthreads();
  S_WRITE(0, 0);
  __syncthreads();
  for (int kt = 0; kt < nk; kt += 2) {
    if (kt + 2 < nk) G_LOAD(0, kt + 2);
    COMPUTE(0);
    S_WRITE(1, 1);
    __syncthreads();
    if (kt + 3 < nk) G_LOAD(1, kt + 3);
    COMPUTE(1);
    if (kt + 2 < nk) S_WRITE(0, 0);
    __syncthreads();
  }
#undef G_LOAD
#undef S_WRITE
#undef COMPUTE
#undef LDFRAG
#undef DOMMA
}
template <int MI>
DI void gemm_tile(const u16* __restrict__ A, int lda, const u16* __restrict__ Bt, int ldb, int K,
                  int m0, int n0, f32x16 (&acc)[MI][2], char* smem) {
  u32x4 pa[2][4], pb[2][4];
  gemm_pref<MI>(A, lda, Bt, ldb, m0, n0, pa, pb);
  gemm_main<MI>(A, lda, Bt, ldb, K, m0, n0, acc, smem, pa, pb);
}

DI void tile_coords(int t, int nN, int& m0, int& n0) {
  const int GM = 32;
  int per = GM * nN;
  int g = t / per, r = t - g * per;
  int n = r / GM, m = g * GM + (r - n * GM);
  m0 = m * 128; n0 = n * 128;
}

DI void conv_job(const float* __restrict__ src, int lds, int scol0, int K, int N, const float* __restrict__ gain,
                 u16* __restrict__ dst, int perm_gu, int gsz, int gid) {
  const int kg = K >> 3;
  const long total = (long)N * kg;
  constexpr int U = 4;
  for (long it = gid; it < total; it += (long)U * gsz) {
    float v[U][8]; int nn[U], kk0[U]; bool ok[U];
#pragma unroll
    for (int u = 0; u < U; u++) {
      const long itu = it + (long)u * gsz;
      ok[u] = itu < total;
      const long iq = ok[u] ? itu : it;
      const int n = (int)(iq % N), k0 = (int)(iq / N) * 8;
      nn[u] = n; kk0[u] = k0;
      int sc;
      if (perm_gu) { int blk = n >> 6, r = n & 63; int j = blk * 32 + (r & 31); sc = (r < 32) ? j : (DFF + j); }
      else sc = scol0 + n;
#pragma unroll
      for (int i = 0; i < 8; i++) v[u][i] = src[(size_t)(k0 + i) * lds + sc];
    }
    if (gain) {
#pragma unroll
      for (int u = 0; u < U; u++)
#pragma unroll
        for (int i = 0; i < 8; i++) v[u][i] *= gain[kk0[u] + i];
    }
#pragma unroll
    for (int u = 0; u < U; u++)
      if (ok[u]) *(uint4*)(dst + (size_t)nn[u] * K + kk0[u]) = (uint4){pack2(v[u][0], v[u][1]), pack2(v[u][2], v[u][3]), pack2(v[u][4], v[u][5]), pack2(v[u][6], v[u][7])};
  }
}

DI void phase_convw(const Params& p, int l) {
  const int TX = tid_opaque();
  const int gsz = gridDim.x * NTHR, gid = blockIdx.x * NTHR + TX;
  u16* W = (u16*)(p.ws + OFF_W);
  const float* w_in = p.in[3] + (size_t)l * 1024 * 8448;
  const float* gmix = p.in[2] + l * 1024;
  conv_job(w_in, 8448, 0, 1024, N_INP, gmix, W + W_IN, 0, gsz, gid);
  if (l == 1) conv_job(p.in[15], 32, 0, 1024, 32, gmix, W + W_IN + (size_t)N_INP * 1024, 0, gsz, gid);
  {
    int r0 = (l == 1) ? N_INP + 32 : N_INP;
    long total = (long)(N_INP_PAD - r0) * 128;
    uint4 z = {0, 0, 0, 0};
    for (long it = gid; it < total; it += gsz) *(uint4*)(W + W_IN + (size_t)r0 * 1024 + it * 8) = z;
  }
  conv_job(w_in, 8448, N_INP, 1024, 3072, gmix, W + W_G, 0, gsz, gid);
  for (int n = 0; n < 3; n++)
    conv_job(p.in[19] + ((size_t)l * 3 + n) * 512 * 1024, 1024, 0, 512, 1024, nullptr, W + W_BR + (size_t)n * 1024 * 512, 0, gsz, gid);
  conv_job(p.in[20] + (size_t)l * 1024 * 1024, 1024, 0, 1024, 1024, nullptr, W + W_OUT, 0, gsz, gid);
  conv_job(p.in[22] + (size_t)l * 1024 * 5632, 5632, 0, 1024, 5632, p.in[21] + l * 1024, W + W_GU, 1, gsz, gid);
  conv_job(p.in[23] + (size_t)l * 2816 * 1024, 1024, 0, 2816, 1024, nullptr, W + W_DN, 0, gsz, gid);
  conv_job(p.in[25] + (size_t)l * 1024 * 1024, 1024, 0, 1024, 1024, p.in[24] + l * 1024, W + W_PG, 0, gsz, gid);
  conv_job(p.in[26] + (size_t)l * 256 * 1024, 1024, 0, 256, 1024, nullptr, W + W_PP, 0, gsz, gid);
  conv_job(p.in[6] + (size_t)l * 64 * 512, 512, 0, 64, 512, nullptr, W + W_W2, 0, gsz, gid);
  conv_job(p.in[8] + (size_t)l * 64 * 512, 512, 0, 64, 512, nullptr, W + W_A2, 0, gsz, gid);
  conv_job(p.in[9] + (size_t)l * 128 * 512, 512, 0, 128, 512, nullptr, W + W_G2, 0, gsz, gid);
  if (l == 1) conv_job(p.in[18], 512, 0, 32, 512, nullptr, W + W_V2, 0, gsz, gid);
  float* kmean = (float*)(p.ws + OFF_SM + SM_KMEAN);
  for (int i = gid; i < 8 * 16 * 8 * 64; i += gsz) kmean[i] = 0.f;
  if (gid < 16) ((int*)(p.ws + OFF_SM + SM_CNT))[gid] = 0;
  for (int i = gid; i < 128 * 4 * 32 * 4; i += gsz) ((unsigned*)(p.ws + OFF_SM + SM_XCH))[i] = 0u;
  if (l == 0) {
    float* ca = (float*)(p.ws + OFF_SM + SM_COSA); float* sa = (float*)(p.ws + OFF_SM + SM_SINA);
    float* cb = (float*)(p.ws + OFF_SM + SM_COSB); float* sb = (float*)(p.ws + OFF_SM + SM_SINB);
    for (int i = gid; i < 4096 * 8; i += gsz) {
      int pos = i >> 3, j = i & 7;
      float inv = 1.0f / powf(500000.0f, (float)(2 * j) / 16.0f);
      float ang = (float)pos * inv;
      ca[i] = cosf(ang); sa[i] = sinf(ang);
    }
    for (int i = gid; i < 4096 * 64; i += gsz) {
      int pos = i >> 6, j = i & 63;
      float inv = 1.0f / powf(10000.0f, (float)j / 63.0f);
      float ang = (float)pos * inv;
      cb[i] = cosf(ang); sb[i] = sinf(ang);
    }
  }
}

DI void phase_prep(const Params& p, const float* __restrict__ x, const float* __restrict__ pl) {
  const int TX = tid_opaque();
  const int lane = TX & 63;
  const int wid = blockIdx.x * (NTHR / 64) + (TX >> 6), nw = gridDim.x * (NTHR / 64);
  u16* XB = (u16*)(p.ws + OFF_XB);
  float* rstd = (float*)(p.ws + OFF_SM + SM_RSTD);
  for (int row = wid; row < T_TOK; row += nw) {
    const float4* xr = (const float4*)(x + (size_t)row * 1024);
    float ss = 0.f;
    float4 xv4[4];
#pragma unroll
    for (int i = 0; i < 4; i++) xv4[i] = xr[lane + 64 * i];
    float4 pv4 = {0.f, 0.f, 0.f, 0.f};
    if (pl) pv4 = ((const float4*)(pl + (size_t)row * 256))[lane];
#pragma unroll
    for (int i = 0; i < 4; i++) {
      const float4 v = xv4[i];
      ss += v.x * v.x + v.y * v.y + v.z * v.z + v.w * v.w;
      uint2 u = {pack2(v.x, v.y), pack2(v.z, v.w)};
      *(uint2*)(XB + (size_t)row * 1024 + (lane + 64 * i) * 4) = u;
    }
#pragma unroll
    for (int o = 32; o > 0; o >>= 1) ss += __shfl_xor(ss, o, 64);
    if (lane == 0) rstd[row] = rsqrtf(ss * (1.0f / 1024.0f) + 1e-6f);
    if (pl) {
      const float4 v = pv4;
      uint2 u = {pack2(v.x, v.y), pack2(v.z, v.w)};
      *(uint2*)((u16*)(p.ws + OFF_PB) + (size_t)row * 256 + lane * 4) = u;
    }
  }
}

DI void phase_final(const Params& p) {
  const int TX = tid_opaque();
  const int lane = TX & 63;
  const int wid = blockIdx.x * (NTHR / 64) + (TX >> 6), nw = gridDim.x * (NTHR / 64);
  const float4* g4 = (const float4*)p.in[27];
  for (int row = wid; row < T_TOK; row += nw) {
    float4* xr = (float4*)(p.out + (size_t)row * 1024);
    float4 v[4];
    float ss = 0.f;
#pragma unroll
    for (int i = 0; i < 4; i++) {
      v[i] = xr[lane + 64 * i];
      ss += v[i].x * v[i].x + v[i].y * v[i].y + v[i].z * v[i].z + v[i].w * v[i].w;
    }
#pragma unroll
    for (int o = 32; o > 0; o >>= 1) ss += __shfl_xor(ss, o, 64);
    float r = rsqrtf(ss * (1.0f / 1024.0f) + 1e-6f);
#pragma unroll
    for (int i = 0; i < 4; i++) {
      float4 g = g4[lane + 64 * i];
      float4 o = {v[i].x * r * g.x, v[i].y * r * g.y, v[i].z * r * g.z, v[i].w * r * g.w};
      xr[lane + 64 * i] = o;
    }
  }
}

DI void phase_inproj(const Params& p, int l, char* smem) {
  const int TX = tid_opaque();
  const u16* XB = (const u16*)(p.ws + OFF_XB);
  const u16* W = (const u16*)(p.ws + OFF_W) + W_IN;
  const float* rstd = (const float*)(p.ws + OFF_SM + SM_RSTD);
  const float* ca = (const float*)(p.ws + OFF_SM + SM_COSA); const float* sa = (const float*)(p.ws + OFF_SM + SM_SINA);
  const float* cb = (const float*)(p.ws + OFF_SM + SM_COSB); const float* sb = (const float*)(p.ws + OFF_SM + SM_SINB);
  u16* ZA = (u16*)(p.ws + OFF_ZA); u16* ZB = (u16*)(p.ws + OFF_ZB); u16* ZC = (u16*)(p.ws + OFF_ZC);
  const int nvalid = (l == 1) ? N_INP + 32 : N_INP;
  const int nN = (l == 1) ? 43 : 42;
  const int ntiles = 256 * nN;
  const int lane = TX & 63, w = TX >> 6, wr = w >> 1, wc = w & 1, l31 = lane & 31, h2 = lane >> 5;
  u32x4 pa[2][4], pb[2][4];
  int t = blockIdx.x, m0 = 0, n0 = 0;
  if (t < ntiles) { tile_coords(t, nN, m0, n0); gemm_pref<2>(XB, 1024, W, 1024, m0, n0, pa, pb); }
  for (; t < ntiles; t += gridDim.x) {
    f32x16 acc[2][2]; zero_acc<2>(acc);
    gemm_main<2>(XB, 1024, W, 1024, 1024, m0, n0, acc, smem, pa, pb);
    const int em0 = m0, en0 = n0;
    float rs[2][16];
#pragma unroll
    for (int mi = 0; mi < 2; mi++)
#pragma unroll
      for (int r = 0; r < 16; r++) rs[mi][r] = rstd[em0 + wr * 64 + mi * 32 + crow(r, h2)];
    if (t + (int)gridDim.x < ntiles) { tile_coords(t + gridDim.x, nN, m0, n0); gemm_pref<2>(XB, 1024, W, 1024, m0, n0, pa, pb); }
    u16* T = (u16*)smem;
#pragma unroll
    for (int ni = 0; ni < 2; ni++) {
      const int cbase = en0 + wc * 64 + ni * 32;
      if (cbase >= nvalid) continue;
      const int c = cbase + l31;
#pragma unroll
      for (int mi = 0; mi < 2; mi++) {
        const int rbase = em0 + wr * 64 + mi * 32;
        const int lrb = wr * 64 + mi * 32, lc = wc * 64 + ni * 32 + l31;
        if (cbase < 1024) {
          const int d = c & 63;
          const float invf = exp2f(-(float)(d & 7) * (18.931568569324174f / 8.0f));
          float cs[16], sn[16];
#pragma unroll
          for (int r = 0; r < 16; r++) {
            const float ang = (float)((rbase + crow(r, h2)) & (SEQ - 1)) * invf;
            float rev = ang * 0.15915494309189535f; rev = rev - floorf(rev);
            cs[r] = __builtin_amdgcn_cosf(rev); sn[r] = __builtin_amdgcn_sinf(rev);
          }
#pragma unroll
          for (int r = 0; r < 16; r++) {
            float v = acc[mi][ni][r] * rs[mi][r];
            float pv = __shfl_xor(v, 8, 64);
            if (d < 16) v = (d < 8) ? (v * cs[r] - pv * sn[r]) : (pv * sn[r] + v * cs[r]);
            if (cbase < 512) v *= 0.125f;
            T[(lrb + crow(r, h2)) * 136 + lc] = f2bf(v);
          }
        } else if (cbase < 1536) {
#pragma unroll
          for (int r = 0; r < 16; r++) T[(lrb + crow(r, h2)) * 136 + lc] = f2bf(acc[mi][ni][r] * rs[mi][r]);
        } else if (cbase < 2560) {
          const int cc = c - 1536;
          const int i2 = (cc & 127) >> 1;
          const float invf = exp2f(-(float)i2 * (13.287712379549449f / 63.0f));
          float cs[16], sn[16];
#pragma unroll
          for (int r = 0; r < 16; r++) {
            const float ang = (float)((rbase + crow(r, h2)) & (SEQ - 1)) * invf;
            float rev = ang * 0.15915494309189535f; rev = rev - floorf(rev);
            cs[r] = __builtin_amdgcn_cosf(rev); sn[r] = __builtin_amdgcn_sinf(rev);
          }
#pragma unroll
          for (int r = 0; r < 16; r++) {
            float v = acc[mi][ni][r] * rs[mi][r];
            float pv = __shfl_xor(v, 1, 64);
            v = (cc & 1) ? (pv * sn[r] + v * cs[r]) : (v * cs[r] - pv * sn[r]);
            if (cbase >= 2048) v *= 0.08838834764831845f;
            T[(lrb + crow(r, h2)) * 136 + lc] = f2bf(v);
          }
        } else if (cbase < 3584) {
#pragma unroll
          for (int r = 0; r < 16; r++) T[(lrb + crow(r, h2)) * 136 + lc] = f2bf(acc[mi][ni][r] * rs[mi][r]);
        } else {
#pragma unroll
          for (int r = 0; r < 16; r++) T[(lrb + crow(r, h2)) * 136 + lc] = f2bf(acc[mi][ni][r] * rs[mi][r]);
        }
      }
    }
    __syncthreads();
    {
      u16* dst; int pitch;
      if (en0 < 1536) { dst = ZA + en0; pitch = ZA_W; }
      else if (en0 < 3584) { dst = ZB + (en0 - 1536); pitch = ZB_W; }
      else { dst = ZC + (en0 - 3584); pitch = ZC_W; }
      const int vch = min(128, nvalid - en0) >> 3;
      u32x4 tv[8];
#pragma unroll
      for (int i = 0; i < 8; i++) { const int idx = TX + 256 * i; tv[i] = *(const u32x4*)(T + (idx >> 4) * 136 + (idx & 15) * 8); }
#pragma unroll
      for (int i = 0; i < 8; i++) {
        const int idx = TX + 256 * i, row = idx >> 4, chn = idx & 15;
        if (chn < vch) *(u32x4*)(dst + (size_t)(em0 + row) * pitch + chn * 8) = tv[i];
      }
    }
  }
}

DI void phase_kmean(const Params& p, char* smem) {
  const int TX = tid_opaque();
  const u16* ZA = (const u16*)(p.ws + OFF_ZA);
  float* kmean = (float*)(p.ws + OFF_SM + SM_KMEAN);
  float* red = (float*)smem;
  const int d = TX & 63, jg = TX >> 6;
  for (int it = blockIdx.x; it < 8 * 16 * 8; it += gridDim.x) {
    int h = it & 7, n = (it >> 3) & 15, b = it >> 7;
    const u16* base = ZA + ((size_t)(b * SEQ + n * 256 + jg * 64)) * ZA_W + 512 + h * 64 + d;
    float s = 0.f;
    for (int j = 0; j < 64; j++) s += bf2f(base[(size_t)j * ZA_W]);
    __syncthreads();
    red[jg * 64 + d] = s;
    __syncthreads();
    if (jg == 0) kmean[((b * 16 + n) * 8 + h) * 64 + d] = (red[d] + red[64 + d] + red[128 + d] + red[192 + d]) * (1.0f / 256.0f);
  }
}

DI void phase_lrprep(const Params& p, int l) {
  const int TX = tid_opaque();
  const u16* ZC = (const u16*)(p.ws + OFF_ZC);
  u16* ALR = (l == 0) ? (u16*)p.out : (u16*)(p.ws + OFF_ACTLR);
  const float* mu = p.in[4] + l * 1792 + 1536;
  const float* vmu = p.in[16];
  const int gsz = gridDim.x * NTHR, gid = blockIdx.x * NTHR + TX;
  for (int it = gid; it < T_TOK * 36; it += gsz) {
    const int row = it / 36, jg = it - row * 36, j0 = jg * 8;
    float out[8];
    if (j0 >= 256 && l == 0) {
#pragma unroll
      for (int e = 0; e < 8; e++) out[e] = 0.f;
    } else {
      const int col = (j0 < 256) ? (1536 + j0) : (1792 + (j0 - 256));
      const float* mup = (j0 < 256) ? (mu + j0) : (vmu + (j0 - 256));
      u32x4 cu = *(const u32x4*)(ZC + (size_t)row * ZC_W + col);
      u32x4 pu = {0u, 0u, 0u, 0u};
      if ((row & (SEQ - 1)) > 0) pu = *(const u32x4*)(ZC + (size_t)(row - 1) * ZC_W + col);
      float cv[8], pv[8];
      unpack8(cu, cv); unpack8(pu, pv);
#pragma unroll
      for (int e = 0; e < 8; e++) {
        float z = cv[e] + (pv[e] - cv[e]) * mup[e];
        if (j0 < 64) z = ftanh(z);
        else if (j0 >= 128 && j0 < 256) z = fsig(z);
        out[e] = z;
      }
    }
    u32x4 u = {pack2(out[0], out[1]), pack2(out[2], out[3]), pack2(out[4], out[5]), pack2(out[6], out[7])};
    *(u32x4*)(ALR + (size_t)row * 288 + j0) = u;
  }
}

DI void attn_item(const Params& p, int b, int h, int qt, char* smem) {
  const int TX = tid_opaque();
  u16* ZA = (u16*)(p.ws + OFF_ZA);
  const float* kmean = (const float*)(p.ws + OFF_SM + SM_KMEAN);
  const int tid = TX, lane = tid & 63, w = tid >> 6, l31 = lane & 31, h2 = lane >> 5;
  const int qblk = qt >> 1, r0 = (qt & 1) * 128;
  u16* sm = (u16*)smem;
  float* km = (float*)(smem + 36864);
  unsigned* uni = (unsigned*)(smem + 40960);
  __syncthreads();
  for (int i = tid; i < qblk * 64; i += NTHR) {
    int n = i >> 6, d = i & 63;
    km[i] = kmean[((b * 16 + n) * 8 + h) * 64 + d];
  }
  if (tid == 0) *uni = 0u;
  const size_t rowbase = (size_t)b * SEQ;
  const int qrow = qblk * 256 + r0 + w * 32 + l31;
  bf16x8 qf[4];
#pragma unroll
  for (int s = 0; s < 4; s++) qf[s] = *(const bf16x8*)(ZA + (rowbase + qrow) * ZA_W + h * 64 + 16 * s + 8 * h2);
  __syncthreads();
  unsigned selmask = 0;
  {
    float qv[32];
#pragma unroll
    for (int s = 0; s < 4; s++)
#pragma unroll
      for (int j = 0; j < 8; j++) qv[s * 8 + j] = bf2f((u16)qf[s][j]);
    float g[15];
#pragma unroll
    for (int n = 0; n < 15; n++) {
      float a = 0.f;
      if (n < qblk) {
#pragma unroll
        for (int s = 0; s < 4; s++) {
          const float4* kp = (const float4*)(km + n * 64 + 16 * s + 8 * h2);
          float4 k0 = kp[0], k1 = kp[1];
          a += qv[s * 8 + 0] * k0.x + qv[s * 8 + 1] * k0.y + qv[s * 8 + 2] * k0.z + qv[s * 8 + 3] * k0.w
             + qv[s * 8 + 4] * k1.x + qv[s * 8 + 5] * k1.y + qv[s * 8 + 6] * k1.z + qv[s * 8 + 7] * k1.w;
        }
      }
      a += __shfl_xor(a, 32, 64);
      g[n] = (n < qblk) ? a : -INFINITY;
    }
#pragma unroll
    for (int pass = 0; pass < 3; pass++) {
      float best = -INFINITY; int bi = -1;
#pragma unroll
      for (int n = 0; n < 15; n++) {
        bool avail = !((selmask >> n) & 1u);
        if (avail && g[n] > best) { best = g[n]; bi = n; }
      }
      if (bi >= 0) selmask |= (1u << bi);
    }
  }
  {
    unsigned wu = 0;
#pragma unroll
    for (int n = 0; n < 15; n++) { if (__ballot((selmask >> n) & 1u) != 0ull) wu |= (1u << n); }
    if (lane == 0) atomicOr(uni, wu);
  }
  __syncthreads();
  const unsigned ublocks = *uni;
  unsigned wunion = 0;
#pragma unroll
  for (int n = 0; n < 15; n++) { if (__ballot((selmask >> n) & 1u) != 0ull) wunion |= (1u << n); }

  f32x16 o[2];
#pragma unroll
  for (int r = 0; r < 16; r++) { o[0][r] = 0.f; o[1][r] = 0.f; }
  float m_run = -INFINITY, l_run = 0.f;
  const float L2E = 1.4426950408889634f;

  const int own_tiles = (r0 + 128) >> 6;
  int cur_n = -1, cur_j = 0;
  auto advance = [&](int& n, int& j) {
    if (n >= 0 && n <= qblk) {
      int nt = (n == qblk) ? own_tiles : 4;
      if (j + 1 < nt) { j++; return; }
    }
    j = 0;
    int nn = n + 1;
    while (nn < qblk && !((ublocks >> nn) & 1u)) nn++;
    n = nn;
  };
  advance(cur_n, cur_j);
  const int lrow = tid >> 3, lk = (tid & 7) * 8;
  u32x4 rk0, rk1, rv0, rv1;
  auto gload = [&](int n, int j) {
    const u16* kb = ZA + (rowbase + n * 256 + j * 64 + lrow) * ZA_W + 512 + h * 64 + lk;
    rk0 = *(const u32x4*)(kb); rk1 = *(const u32x4*)(kb + (size_t)32 * ZA_W);
    rv0 = *(const u32x4*)(kb + 512); rv1 = *(const u32x4*)(kb + (size_t)32 * ZA_W + 512);
  };
  auto swrite = [&](int st) {
    u16* dk = sm + st * 9216;
    *(u32x4*)(dk + lrow * 72 + lk) = rk0; *(u32x4*)(dk + (lrow + 32) * 72 + lk) = rk1;
    *(u32x4*)(dk + 4608 + lrow * 72 + lk) = rv0; *(u32x4*)(dk + 4608 + (lrow + 32) * 72 + lk) = rv1;
  };
  gload(cur_n, cur_j);
  swrite(0);
  __syncthreads();
  int st = 0;
  while (cur_n <= qblk) {
    int nx_n = cur_n, nx_j = cur_j;
    advance(nx_n, nx_j);
    const bool more = (nx_n <= qblk);
    if (more) gload(nx_n, nx_j);
    const u16* sK = sm + st * 9216;
    const u16* sV = sK + 4608;
    const bool own = (cur_n == qblk);
    bool active = own ? (cur_j * 64 <= r0 + w * 32 + 31) : (((wunion >> cur_n) & 1u) != 0u);
    if (active) {
      f32x16 sc[2];
#pragma unroll
      for (int mt = 0; mt < 2; mt++) {
#pragma unroll
        for (int r = 0; r < 16; r++) sc[mt][r] = 0.f;
#pragma unroll
        for (int s = 0; s < 4; s++) {
          bf16x8 a = *(const bf16x8*)(sK + (mt * 32 + l31) * 72 + 16 * s + 8 * h2);
          sc[mt] = MFMA(a, qf[s], sc[mt]);
        }
      }
      const bool selq = own ? true : (((selmask >> cur_n) & 1u) != 0u);
      const float bias = selq ? 0.f : -INFINITY;
      const int qi = r0 + w * 32 + l31;
      const bool diag = own && (cur_j * 64 + 63 > r0 + w * 32);
      float tmax = -INFINITY;
      if (diag) {
#pragma unroll
        for (int mt = 0; mt < 2; mt++)
#pragma unroll
          for (int r = 0; r < 16; r++) {
            const bool keep = (cur_j * 64 + mt * 32 + crow(r, h2)) <= qi;
            const float v = keep ? sc[mt][r] : -INFINITY;
            sc[mt][r] = v;
            tmax = fmaxf(tmax, v);
          }
      } else {
#pragma unroll
        for (int mt = 0; mt < 2; mt++)
#pragma unroll
          for (int r = 0; r < 16; r++) { const float v = sc[mt][r] + bias; sc[mt][r] = v; tmax = fmaxf(tmax, v); }
      }
      tmax = fmaxf(tmax, __shfl_xor(tmax, 32, 64)) * L2E;
      float m_new = fmaxf(m_run, tmax);
      float m_use = (m_new == -INFINITY) ? 0.f : m_new;
      float alpha = __builtin_amdgcn_exp2f(m_run - m_use);
      m_run = m_new;
      float psum = 0.f;
#pragma unroll
      for (int mt = 0; mt < 2; mt++)
#pragma unroll
        for (int r = 0; r < 16; r++) { float pe = __builtin_amdgcn_exp2f(fmaf(sc[mt][r], L2E, -m_use)); sc[mt][r] = pe; psum += pe; }
      l_run = l_run * alpha + psum;
#pragma unroll
      for (int r = 0; r < 16; r++) { o[0][r] *= alpha; o[1][r] *= alpha; }
      const int q4 = (lane & 15) >> 2, p4 = lane & 3, gsel = (lane >> 4) & 1;
#pragma unroll
      for (int mt = 0; mt < 2; mt++) {
#pragma unroll
        for (int s2 = 0; s2 < 2; s2++) {
          bf16x8 pf = pack8(sc[mt][8 * s2 + 0], sc[mt][8 * s2 + 1], sc[mt][8 * s2 + 2], sc[mt][8 * s2 + 3],
                            sc[mt][8 * s2 + 4], sc[mt][8 * s2 + 5], sc[mt][8 * s2 + 6], sc[mt][8 * s2 + 7]);
          const int key0 = mt * 32 + 16 * s2 + 4 * h2 + q4;
#pragma unroll
          for (int dt = 0; dt < 2; dt++) {
            s16x4 lo = tr_read(sV + key0 * 72 + dt * 32 + 16 * gsel + 4 * p4);
            s16x4 hi = tr_read(sV + (key0 + 8) * 72 + dt * 32 + 16 * gsel + 4 * p4);
            o[dt] = MFMA(cat44(lo, hi), pf, o[dt]);
          }
        }
      }
    }
    if (more) swrite(st ^ 1);
    __syncthreads();
    st ^= 1;
    cur_n = nx_n; cur_j = nx_j;
  }
  float l_tot = l_run + __shfl_xor(l_run, 32, 64);
  float inv = 1.f / l_tot;
  u16* yo = ZA + (rowbase + qrow) * ZA_W + h * 64;
#pragma unroll
  for (int dt = 0; dt < 2; dt++)
#pragma unroll
    for (int g = 0; g < 4; g++) {
      uint2 u = {pack2(o[dt][4 * g] * inv, o[dt][4 * g + 1] * inv), pack2(o[dt][4 * g + 2] * inv, o[dt][4 * g + 3] * inv)};
      *(uint2*)(yo + dt * 32 + 8 * g + 4 * h2) = u;
    }
}

DI void retention_block(const Params& p, int b, int h, char* smem) {
  const int TX = tid_opaque();
  u16* ZB = (u16*)(p.ws + OFF_ZB);
  const int tid = TX, lane = tid & 63, w = tid >> 6, l31 = lane & 31, h2 = lane >> 5;
  const int qt = w & 1, eh = w >> 1;
  u16* sK = (u16*)smem;
  u16* sV = sK + 64 * 136;
  u16* sR = sV + 64 * 136;
  float* exch = (float*)(smem + (64 * 136 * 2 + 128 * 136) * 2);
  const float gamma = 1.0f - exp2f(-5.0f - (float)h);
  const float lg = log2f(gamma);
  const float g64 = exp2f(lg * 64.f);
  __syncthreads();
  for (int i = tid; i < 128 * 136 / 2; i += NTHR) ((unsigned*)sR)[i] = 0u;
  f32x16 racc[4];
#pragma unroll
  for (int dt = 0; dt < 4; dt++)
#pragma unroll
    for (int r = 0; r < 16; r++) racc[dt][r] = 0.f;
  const int q4 = (lane & 15) >> 2, p4 = lane & 3, gsel = (lane >> 4) & 1;
  const int lrow = tid >> 4, lc = (tid & 15) * 8;
  for (int n = 0; n < SEQ / 64; n++) {
    const size_t rb = (size_t)b * SEQ + n * 64;
#pragma unroll
    for (int i = 0; i < 4; i++) {
      int j = lrow + 16 * i;
      const u16* src = ZB + (rb + j) * ZB_W + 512 + h * 128 + lc;
      uint4 kk = *(const uint4*)src;
      uint4 vv = *(const uint4*)(src + 512);
      float z = exp2f(lg * (float)(63 - j));
      uint4 ks = {pack2(bflo(kk.x) * z, bfhi(kk.x) * z), pack2(bflo(kk.y) * z, bfhi(kk.y) * z),
                  pack2(bflo(kk.z) * z, bfhi(kk.z) * z), pack2(bflo(kk.w) * z, bfhi(kk.w) * z)};
      *(uint4*)(sK + j * 136 + lc) = ks;
      *(uint4*)(sV + j * 136 + lc) = vv;
    }
    const int qi = 32 * qt + l31;
    bf16x8 qf[8];
#pragma unroll
    for (int s = 0; s < 8; s++) qf[s] = *(const bf16x8*)(ZB + (rb + qi) * ZB_W + h * 128 + 16 * s + 8 * h2);
    __syncthreads();
    f32x16 acc[2];
#pragma unroll
    for (int et = 0; et < 2; et++) {
#pragma unroll
      for (int r = 0; r < 16; r++) acc[et][r] = 0.f;
#pragma unroll
      for (int s = 0; s < 8; s++) {
        bf16x8 a = *(const bf16x8*)(sR + (32 * (2 * eh + et) + l31) * 136 + 16 * s + 8 * h2);
        acc[et] = MFMA(a, qf[s], acc[et]);
      }
#pragma unroll
      for (int r = 0; r < 16; r++) acc[et][r] *= g64;
    }
    for (int kt = 0; kt <= qt; kt++) {
      f32x16 sc;
#pragma unroll
      for (int r = 0; r < 16; r++) sc[r] = 0.f;
#pragma unroll
      for (int s = 0; s < 8; s++) {
        bf16x8 a = *(const bf16x8*)(sK + (32 * kt + l31) * 136 + 16 * s + 8 * h2);
        sc = MFMA(a, qf[s], sc);
      }
      if (kt == qt) {
#pragma unroll
        for (int r = 0; r < 16; r++) if (crow(r, h2) > l31) sc[r] = 0.f;
      }
#pragma unroll
      for (int s2 = 0; s2 < 2; s2++) {
        bf16x8 pf = pack8(sc[8 * s2 + 0], sc[8 * s2 + 1], sc[8 * s2 + 2], sc[8 * s2 + 3],
                          sc[8 * s2 + 4], sc[8 * s2 + 5], sc[8 * s2 + 6], sc[8 * s2 + 7]);
        const int key0 = 32 * kt + 16 * s2 + 4 * h2 + q4;
#pragma unroll
        for (int et = 0; et < 2; et++) {
          s16x4 lo = tr_read(sV + key0 * 136 + 32 * (2 * eh + et) + 16 * gsel + 4 * p4);
          s16x4 hi = tr_read(sV + (key0 + 8) * 136 + 32 * (2 * eh + et) + 16 * gsel + 4 * p4);
          acc[et] = MFMA(cat44(lo, hi), pf, acc[et]);
        }
      }
    }
    const float fi = exp2f(lg * (float)(qi - 63));
    float s1 = 0.f, s2s = 0.f;
#pragma unroll
    for (int et = 0; et < 2; et++)
#pragma unroll
      for (int r = 0; r < 16; r++) { float y = acc[et][r] * fi; acc[et][r] = y; s1 += y; s2s += y * y; }
    s1 += __shfl_xor(s1, 32, 64); s2s += __shfl_xor(s2s, 32, 64);
    if (h2 == 0) { exch[(w * 32 + l31) * 2] = s1; exch[(w * 32 + l31) * 2 + 1] = s2s; }
    __syncthreads();
    {
      float o1 = exch[((w ^ 2) * 32 + l31) * 2], o2 = exch[((w ^ 2) * 32 + l31) * 2 + 1];
      float mu = (s1 + o1) * (1.0f / 128.0f);
      float var = (s2s + o2) * (1.0f / 128.0f) - mu * mu;
      float rs = rsqrtf(fmaxf(var, 0.f) + 1e-6f);
      u16* rowp = ZB + (rb + qi) * ZB_W;
#pragma unroll
      for (int et = 0; et < 2; et++)
#pragma unroll
        for (int g = 0; g < 4; g++) {
          int e = 32 * (2 * eh + et) + 8 * g + 4 * h2;
          uint2 gg = *(const uint2*)(rowp + 1536 + h * 128 + e);
          float g0 = bflo(gg.x), g1 = bfhi(gg.x), g2 = bflo(gg.y), g3 = bfhi(gg.y);
          float y0 = (acc[et][4 * g] - mu) * rs * g0 * sigmoidf_(g0);
          float y1 = (acc[et][4 * g + 1] - mu) * rs * g1 * sigmoidf_(g1);
          float y2 = (acc[et][4 * g + 2] - mu) * rs * g2 * sigmoidf_(g2);
          float y3 = (acc[et][4 * g + 3] - mu) * rs * g3 * sigmoidf_(g3);
          uint2 u = {pack2(y0, y1), pack2(y2, y3)};
          *(uint2*)(rowp + h * 128 + e) = u;
        }
    }
#pragma unroll
    for (int dt = 0; dt < 4; dt++) {
#pragma unroll
      for (int r = 0; r < 16; r++) racc[dt][r] *= g64;
    }
#pragma unroll
    for (int s = 0; s < 4; s++) {
      const int tk0 = 16 * s + 4 * h2 + q4;
      s16x4 blo = tr_read(sV + tk0 * 136 + 32 * w + 16 * gsel + 4 * p4);
      s16x4 bhi = tr_read(sV + (tk0 + 8) * 136 + 32 * w + 16 * gsel + 4 * p4);
      bf16x8 bfrag = cat44(blo, bhi);
#pragma unroll
      for (int dt = 0; dt < 4; dt++) {
        s16x4 alo = tr_read(sK + tk0 * 136 + 32 * dt + 16 * gsel + 4 * p4);
        s16x4 ahi = tr_read(sK + (tk0 + 8) * 136 + 32 * dt + 16 * gsel + 4 * p4);
        racc[dt] = MFMA(cat44(alo, ahi), bfrag, racc[dt]);
      }
    }
#pragma unroll
    for (int dt = 0; dt < 4; dt++)
#pragma unroll
      for (int g = 0; g < 4; g++) {
        uint2 u = {pack2(racc[dt][4 * g], racc[dt][4 * g + 1]), pack2(racc[dt][4 * g + 2], racc[dt][4 * g + 3])};
        *(uint2*)(sR + (32 * w + l31) * 136 + 32 * dt + 8 * g + 4 * h2) = u;
      }
    __syncthreads();
  }
}

DI void rwkv_epi(const Params& p, int b, int h, int half, int cc, int partner, const unsigned long long* xch,
                 unsigned long long g1, unsigned long long g2, unsigned tag,
                 const float* ybuf, const float* stV, const u16* stG, const float* stS, const float* par, int tid) {
  u16* YC = (u16*)(p.ws + OFF_YC);
  const int ti = tid >> 3, part = tid & 7, slot = cc & 1;
  {
    const unsigned long long* src = xch + ((size_t)(partner * 4 + (cc & 3)) * 32 + ti) * 2;
    unsigned spins = 0;
    while ((unsigned)(g1 >> 32) != tag || (unsigned)(g2 >> 32) != tag) {
      __builtin_amdgcn_s_sleep(1);
      g1 = __hip_atomic_load(src, __ATOMIC_RELAXED, __HIP_MEMORY_SCOPE_AGENT);
      g2 = __hip_atomic_load(src + 1, __ATOMIC_RELAXED, __HIP_MEMORY_SCOPE_AGENT);
      if (++spins > (1u << 22)) break;
    }
  }
  const float o1 = __uint_as_float((unsigned)(g1 & 0xffffffffull)), o2 = __uint_as_float((unsigned)(g2 & 0xffffffffull));
  const float s1 = stS[(slot * 32 + ti) * 4 + 0] + o1, s2 = stS[(slot * 32 + ti) * 4 + 1] + o2;
  const float bonus = stS[(slot * 32 + ti) * 4 + 2];
  const float mean = s1 * (1.f / 64.f);
  const float var = fmaxf(s2 * (1.f / 64.f) - mean * mean, 0.f);
  const float rsd = rsqrtf(var + 64e-5f);
  float o[4];
#pragma unroll
  for (int e = 0; e < 4; e++) {
    const int rr = part * 4 + e, c = half * 32 + rr;
    const float y = (ybuf[slot * 1024 + ti * 32 + rr] - mean) * rsd * par[8 * 64 + c] + par[9 * 64 + c] + bonus * stV[slot * 1024 + ti * 32 + rr];
    o[e] = y * bf2f(stG[slot * 1024 + ti * 32 + rr]);
  }
  uint2 u = {pack2(o[0], o[1]), pack2(o[2], o[3])};
  *(uint2*)(YC + ((size_t)b * SEQ + cc * 32 + ti) * 512 + h * 64 + half * 32 + part * 4) = u;
}

DI void rwkv_block(const Params& p, int l, int b, int h, int half, char* smem) {
  const int TX = tid_opaque();
  const u16* ZC = (const u16*)(p.ws + OFF_ZC);
  u16* YC = (u16*)(p.ws + OFF_YC);
  u16* VF = (u16*)(p.ws + OFF_VF);
  const u16* Wt = (const u16*)(p.ws + OFF_W);
  const int tid = TX, lane = tid & 63, wv = tid >> 6, l31 = lane & 31, h2 = lane >> 5;
  float* opKK = (float*)smem;
  float* opW  = opKK + 2048;
  float* opB  = opW + 2048;
  float* opK  = opB + 2048;
  float* opWR = opK + 2048;
  float* opV  = opWR + 2048;
  u16*   opG  = (u16*)(smem + 49152);
  float* scal = (float*)(smem + 53248);
  float* ybuf = (float*)(smem + 53760);
  float* par  = (float*)(smem + 61952);
  float* stV  = (float*)(smem + 64768);
  u16*   stG  = (u16*)(smem + 72960);
  float* stS  = (float*)(smem + 77056);
  const int me = (b * 8 + h) * 2 + half, partner = me ^ 1;
  unsigned long long* xch = (unsigned long long*)(p.ws + OFF_SM + SM_XCH);
  const u16* ALR = (l == 0) ? (const u16*)p.out : (const u16*)(p.ws + OFF_ACTLR);
  __syncthreads();
  {
    const float* mu = p.in[4] + l * 1792;
    if (tid < 64) {
      const int c = h * 64 + tid;
      par[0 * 64 + tid] = mu[c]; par[1 * 64 + tid] = mu[512 + c]; par[2 * 64 + tid] = mu[1024 + c];
      par[3 * 64 + tid] = p.in[5][l * 512 + c];
      par[4 * 64 + tid] = p.in[7][l * 512 + c];
      par[5 * 64 + tid] = p.in[10][l * 512 + c];
      par[6 * 64 + tid] = p.in[11][l * 512 + c];
      par[7 * 64 + tid] = p.in[12][l * 512 + c];
      par[8 * 64 + tid] = p.in[13][l * 512 + c];
      par[9 * 64 + tid] = p.in[14][l * 512 + c];
      par[10 * 64 + tid] = (l == 1) ? p.in[17][c] : 0.f;
    }
  }
  const int koff = wv * 64;
  const u16* wsrc = Wt + ((wv == 0) ? W_W2 : (wv == 1) ? W_A2 : (wv == 2) ? W_G2 : (W_G2 + 64));
  const int ldw = (wv < 2) ? 64 : 128;
  bf16x8 wf[2][4];
#pragma unroll
  for (int nt = 0; nt < 2; nt++)
#pragma unroll
    for (int s = 0; s < 4; s++) wf[nt][s] = *(const bf16x8*)(wsrc + (size_t)(h * 64 + nt * 32 + l31) * ldw + 16 * s + 8 * h2);
  f2 S[4];
#pragma unroll
  for (int j = 0; j < 4; j++) S[j] = (f2){0.f, 0.f};
  const int kq = lane & 7, rs = lane >> 3;
  const int rloc = wv * 8 + rs, vrow = half * 32 + rloc;
  const int ti = tid >> 3, c0 = (tid & 7) * 8;
  bf16x8 af0, af1, af2, af3, av0, av1;
  u32x4 pr_c, pr_p, pk_c, pk_p, pv_c, pv_p, pvf;
  const u32x4 zero4 = {0u, 0u, 0u, 0u};
  auto issue = [&](int ch) {
    const int s0 = ch * 32;
    const size_t rb = (size_t)b * SEQ + s0;
    {
      const u16* ap = ALR + (rb + l31) * 288 + koff + 8 * h2;
      af0 = *(const bf16x8*)(ap); af1 = *(const bf16x8*)(ap + 16); af2 = *(const bf16x8*)(ap + 32); af3 = *(const bf16x8*)(ap + 48);
      const bf16x8 zz = {0, 0, 0, 0, 0, 0, 0, 0};
      av0 = zz; av1 = zz;
      if (l == 1 && wv == 3) { const u16* vp = ALR + (rb + l31) * 288 + 256 + 8 * h2; av0 = *(const bf16x8*)(vp); av1 = *(const bf16x8*)(vp + 16); }
    }
    const u16* cp = ZC + (rb + ti) * ZC_W + h * 64 + c0;
    pr_c = *(const u32x4*)cp; pk_c = *(const u32x4*)(cp + 512); pv_c = *(const u32x4*)(cp + 1024);
    pr_p = zero4; pk_p = zero4; pv_p = zero4;
    if (s0 + ti > 0) { pr_p = *(const u32x4*)(cp - ZC_W); pk_p = *(const u32x4*)(cp - ZC_W + 512); pv_p = *(const u32x4*)(cp - ZC_W + 1024); }
    pvf = zero4;
    if (l == 1) pvf = *(const u32x4*)(VF + (rb + ti) * 512 + h * 64 + c0);
  };
  issue(0);
  __syncthreads();
  for (int ch = 0; ch < SEQ / 32; ch++) {
    const int s0 = ch * 32;
    const size_t rb = (size_t)b * SEQ + s0;
    const bf16x8 caf0 = af0, caf1 = af1, caf2 = af2, caf3 = af3, cav0 = av0, cav1 = av1;
    float zr[8], zk[8], zv[8], vfv[8];
    {
      float a[8], bb[8];
      unpack8(pr_c, a); unpack8(pr_p, bb);
#pragma unroll
      for (int e = 0; e < 8; e++) zr[e] = a[e] + (bb[e] - a[e]) * par[0 * 64 + c0 + e];
      unpack8(pk_c, a); unpack8(pk_p, bb);
#pragma unroll
      for (int e = 0; e < 8; e++) zk[e] = a[e] + (bb[e] - a[e]) * par[1 * 64 + c0 + e];
      unpack8(pv_c, a); unpack8(pv_p, bb);
#pragma unroll
      for (int e = 0; e < 8; e++) zv[e] = a[e] + (bb[e] - a[e]) * par[2 * 64 + c0 + e];
      unpack8(pvf, vfv);
    }
    {
      f32x16 pa[2];
#pragma unroll
      for (int nt = 0; nt < 2; nt++)
#pragma unroll
        for (int r = 0; r < 16; r++) pa[nt][r] = 0.f;
      pa[0] = MFMA(caf0, wf[0][0], pa[0]); pa[1] = MFMA(caf0, wf[1][0], pa[1]);
      pa[0] = MFMA(caf1, wf[0][1], pa[0]); pa[1] = MFMA(caf1, wf[1][1], pa[1]);
      pa[0] = MFMA(caf2, wf[0][2], pa[0]); pa[1] = MFMA(caf2, wf[1][2], pa[1]);
      pa[0] = MFMA(caf3, wf[0][3], pa[0]); pa[1] = MFMA(caf3, wf[1][3], pa[1]);
      float* dst = (wv == 0) ? opW : (wv == 1) ? opB : (wv == 2) ? opKK : opK;
#pragma unroll
      for (int nt = 0; nt < 2; nt++)
#pragma unroll
        for (int r = 0; r < 16; r++) dst[crow(r, h2) * 64 + nt * 32 + l31] = pa[nt][r];
      if (l == 1 && wv == 3) {
#pragma unroll
        for (int nt = 0; nt < 2; nt++)
#pragma unroll
          for (int r = 0; r < 16; r++) pa[nt][r] = 0.f;
#pragma unroll
        for (int nt = 0; nt < 2; nt++) {
          bf16x8 w0v = *(const bf16x8*)(Wt + W_V2 + (size_t)(h * 64 + nt * 32 + l31) * 32 + 8 * h2);
          bf16x8 w1v = *(const bf16x8*)(Wt + W_V2 + (size_t)(h * 64 + nt * 32 + l31) * 32 + 16 + 8 * h2);
          pa[nt] = MFMA(cav0, w0v, pa[nt]);
          pa[nt] = MFMA(cav1, w1v, pa[nt]);
        }
#pragma unroll
        for (int nt = 0; nt < 2; nt++)
#pragma unroll
          for (int r = 0; r < 16; r++) opV[crow(r, h2) * 64 + nt * 32 + l31] = pa[nt][r];
      }
    }
    lds_barrier();
    {
      typedef float f4 __attribute__((ext_vector_type(4)));
      u32x4 gu;
      float dec[8], av[8];
#define LD8(dst, ptr) do { const f4 t0_ = *(const f4*)(ptr); const f4 t1_ = *(const f4*)((ptr) + 4); \
        dst[0] = t0_[0]; dst[1] = t0_[1]; dst[2] = t0_[2]; dst[3] = t0_[3]; dst[4] = t1_[0]; dst[5] = t1_[1]; dst[6] = t1_[2]; dst[7] = t1_[3]; } while (0)
#define ST8(ptr, src) do { f4 t0_ = {src[0], src[1], src[2], src[3]}; f4 t1_ = {src[4], src[5], src[6], src[7]}; \
        *(f4*)(ptr) = t0_; *(f4*)((ptr) + 4) = t1_; } while (0)
      {
        float g0[8], g1[8], wpre[8], apre[8], pw0[8], pa0[8];
        LD8(g0, opKK + ti * 64 + c0); LD8(g1, opK + ti * 64 + c0);
        LD8(wpre, opW + ti * 64 + c0); LD8(apre, opB + ti * 64 + c0);
        LD8(pw0, par + 3 * 64 + c0); LD8(pa0, par + 4 * 64 + c0);
        gu = (u32x4){pack2(g0[0] + g1[0], g0[1] + g1[1]), pack2(g0[2] + g1[2], g0[3] + g1[3]),
                     pack2(g0[4] + g1[4], g0[5] + g1[5]), pack2(g0[6] + g1[6], g0[7] + g1[7])};
#pragma unroll
        for (int e = 0; e < 8; e++) {
          dec[e] = __expf(-0.6065306597126334f * fsig(wpre[e] + pw0[e]));
          av[e] = fsig(apre[e] + pa0[e]);
        }
      }
      float ssq = 0.f, brs = 0.f, krs = 0.f, bns = 0.f;
      float kkr[8], dwr[8], kpv[8];
      const size_t grow = rb + ti;
      {
        float vgp[8], pkk[8], pka[8], prk[8], pv0[8];
        LD8(vgp, opV + ti * 64 + c0); LD8(pkk, par + 5 * 64 + c0);
        LD8(pka, par + 6 * 64 + c0); LD8(prk, par + 7 * 64 + c0); LD8(pv0, par + 10 * 64 + c0);
#pragma unroll
        for (int e = 0; e < 8; e++) {
          float vv = zv[e];
          if (l == 1) vv = vv + (vfv[e] - vv) * fsig(pv0[e] + vgp[e]);
          zv[e] = vv;
          kkr[e] = zk[e] * pkk[e];
          ssq += kkr[e] * kkr[e];
          const float kp = zk[e] * (1.f + (av[e] - 1.f) * pka[e]);
          dwr[e] = dec[e] * zr[e]; kpv[e] = kp;
          krs += kp * zr[e];
          bns += zr[e] * kp * prk[e];
        }
      }
      ssq = red8(ssq);
      const float inv = (ssq > 1e-24f) ? rsqrtf(ssq) : 1e12f;
      float kkv[8], bvv[8];
#pragma unroll
      for (int e = 0; e < 8; e++) { kkv[e] = kkr[e] * inv; bvv[e] = kkv[e] * av[e]; brs += bvv[e] * zr[e]; }
      brs = red8(brs); krs = red8(krs); bns = red8(bns);
      *(u32x4*)(opG + ti * 64 + c0) = gu;
      ST8(opW + ti * 64 + c0, dec); ST8(opWR + ti * 64 + c0, dwr); ST8(opK + ti * 64 + c0, kpv); ST8(opV + ti * 64 + c0, zv);
      ST8(opKK + ti * 64 + c0, kkv); ST8(opB + ti * 64 + c0, bvv);
      if ((tid & 7) == 0) { scal[ti] = brs; scal[32 + ti] = krs; scal[64 + ti] = bns; }
      if (l == 0 && half == 0) {
        u32x4 u = {pack2(zv[0], zv[1]), pack2(zv[2], zv[3]), pack2(zv[4], zv[5]), pack2(zv[6], zv[7])};
        *(u32x4*)(VF + grow * 512 + h * 64 + c0) = u;
      }
#undef LD8
#undef ST8
    }
    lds_barrier();
    unsigned long long pg1 = 0ull, pg2 = 0ull;
    if (ch >= 1) {
      const unsigned long long* src = xch + ((size_t)(partner * 4 + ((ch - 1) & 3)) * 32 + ti) * 2;
      pg1 = __hip_atomic_load(src, __ATOMIC_RELAXED, __HIP_MEMORY_SCOPE_AGENT);
      pg2 = __hip_atomic_load(src + 1, __ATOMIC_RELAXED, __HIP_MEMORY_SCOPE_AGENT);
    }
    if (ch + 1 < SEQ / 32) issue(ch + 1);
    float* yb = ybuf + (ch & 1) * 1024;
#define SCAN_STEP(T, YOUT) do { \
      const f2* pkk = (const f2*)(opKK + (T) * 64 + 8 * kq); const f2* pw = (const f2*)(opW + (T) * 64 + 8 * kq); \
      const f2* pb = (const f2*)(opB + (T) * 64 + 8 * kq); const f2* pk = (const f2*)(opK + (T) * 64 + 8 * kq); \
      const f2* pwr = (const f2*)(opWR + (T) * 64 + 8 * kq); \
      const float vv = opV[(T) * 64 + vrow]; const float br = scal[(T)], kr = scal[32 + (T)]; \
      f2 kk4[4], w4[4], b4[4], k4[4], wr4[4]; \
      _Pragma("unroll") for (int j = 0; j < 4; j++) { kk4[j] = pkk[j]; w4[j] = pw[j]; b4[j] = pb[j]; k4[j] = pk[j]; wr4[j] = pwr[j]; } \
      const f2 v0v = {vv, vv}; \
      f2 p0 = (S[0] * kk4[0] + S[1] * kk4[1]) + (S[2] * kk4[2] + S[3] * kk4[3]); \
      f2 q0 = (S[0] * wr4[0] + S[1] * wr4[1]) + (S[2] * wr4[2] + S[3] * wr4[3]); \
      f2 tq[4]; \
      _Pragma("unroll") for (int j = 0; j < 4; j++) tq[j] = S[j] * w4[j] + v0v * k4[j];     \
      const float P0 = red8(p0[0] + p0[1]), Q0 = red8(q0[0] + q0[1]); \
      const float sa0 = -P0; const f2 sa0v = {sa0, sa0}; \
      _Pragma("unroll") for (int j = 0; j < 4; j++) S[j] = sa0v * b4[j] + tq[j]; \
      YOUT = Q0 + sa0 * br + vv * kr; } while (0)
#pragma unroll 1
    for (int t = 0; t < 32; t += 4) {
      float y0_, y1_, y2_, y3_;
      SCAN_STEP(t, y0_);
      SCAN_STEP(t + 1, y1_);
      SCAN_STEP(t + 2, y2_);
      SCAN_STEP(t + 3, y3_);
      if (kq == 0) { yb[t * 32 + rloc] = y0_; yb[(t + 1) * 32 + rloc] = y1_; yb[(t + 2) * 32 + rloc] = y2_; yb[(t + 3) * 32 + rloc] = y3_; }
    }
#undef SCAN_STEP
    lds_barrier();
    {
      const int part = tid & 7, slot = ch & 1;
      float s1 = 0.f, s2 = 0.f;
      float yv_[4], vv_[4]; u16 gg_[4];
#pragma unroll
      for (int e = 0; e < 4; e++) {
        const int rr = part * 4 + e;
        yv_[e] = yb[ti * 32 + rr]; vv_[e] = opV[ti * 64 + half * 32 + rr]; gg_[e] = opG[ti * 64 + half * 32 + rr];
      }
      const float bon_ = scal[64 + ti];
#pragma unroll
      for (int e = 0; e < 4; e++) {
        const int rr = part * 4 + e;
        s1 += yv_[e]; s2 += yv_[e] * yv_[e];
        stV[slot * 1024 + ti * 32 + rr] = vv_[e];
        stG[slot * 1024 + ti * 32 + rr] = gg_[e];
      }
      s1 = red8(s1); s2 = red8(s2);
      if (part == 0) {
        stS[(slot * 32 + ti) * 4 + 0] = s1; stS[(slot * 32 + ti) * 4 + 1] = s2; stS[(slot * 32 + ti) * 4 + 2] = bon_;
        const unsigned long long tg = (unsigned long long)(unsigned)(ch + 1) << 32;
        unsigned long long* dst = xch + ((size_t)(me * 4 + (ch & 3)) * 32 + ti) * 2;
        __hip_atomic_store(dst, tg | (unsigned long long)__float_as_uint(s1), __ATOMIC_RELAXED, __HIP_MEMORY_SCOPE_AGENT);
        __hip_atomic_store(dst + 1, tg | (unsigned long long)__float_as_uint(s2), __ATOMIC_RELAXED, __HIP_MEMORY_SCOPE_AGENT);
      }
    }
    lds_barrier();
    if (ch >= 1) rwkv_epi(p, b, h, half, ch - 1, partner, xch, pg1, pg2, (unsigned)ch, ybuf, stV, stG, stS, par, tid);
  }
  lds_barrier();
  rwkv_epi(p, b, h, half, SEQ / 32 - 1, partner, xch, 0ull, 0ull, (unsigned)(SEQ / 32), ybuf, stV, stG, stS, par, tid);
  lds_barrier();
}

DI void phase_mixers(const Params& p, int l, char* smem) {
  const int TX = tid_opaque();
  const int bid = blockIdx.x;
  int* cnt = (int*)(p.ws + OFF_SM + SM_CNT);
  __shared__ int s_item;
  if (EN_RWKV && bid < 128) { rwkv_block(p, l, bid >> 4, (bid >> 1) & 7, bid & 1, smem); }
  else if (EN_RET && bid >= 128 && bid < 160) { int i = bid - 128; retention_block(p, i >> 2, i & 3, smem); }
  if (!EN_ATT) return;
  for (;;) {
    __syncthreads();
    if (TX == 0) s_item = atomicAdd(cnt, 1);
    __syncthreads();
    int it = s_item;
    if (it >= 2048) break;
    int qt = 31 - (it >> 6), bh = it & 63;
    attn_item(p, bh >> 3, bh & 7, qt, smem);
  }
}

DI void phase_merge(const Params& p, char* smem) {
  const int TX = tid_opaque();
  const u16* XB = (const u16*)(p.ws + OFF_XB);
  const u16* W = (const u16*)(p.ws + OFF_W);
  const float* rstd = (const float*)(p.ws + OFF_SM + SM_RSTD);
  u16* MG = (u16*)(p.ws + OFF_MERGED);
  const int lane = TX & 63, w = TX >> 6, wr = w >> 1, wc = w & 1, l31 = lane & 31, h2 = lane >> 5;
  const int ntiles = 256 * 8;
  u16* T = (u16*)smem;
  for (int t = blockIdx.x; t < ntiles; t += gridDim.x) {
    int m0, n0; tile_coords(t, 8, m0, n0);
    bool first = true;
#pragma unroll 1
    for (int n = 0; n < 3; n++) {
      bool en = (n == 0) ? (EN_ATT != 0) : (n == 1) ? (EN_RET != 0) : (EN_RWKV != 0);
      if (!en) continue;
      f32x16 acc[2][2]; zero_acc<2>(acc);
      gemm_tile<2>(XB, 1024, W + W_G + (size_t)n * 1024 * 1024, 1024, 1024, m0, n0, acc, smem);
      unsigned gtp[2][2][8];
      {
        float rs[2][16];
#pragma unroll
        for (int mi = 0; mi < 2; mi++)
#pragma unroll
          for (int r = 0; r < 16; r++) rs[mi][r] = rstd[m0 + wr * 64 + mi * 32 + crow(r, h2)];
#pragma unroll
        for (int mi = 0; mi < 2; mi++)
#pragma unroll
          for (int ni = 0; ni < 2; ni++)
#pragma unroll
            for (int q = 0; q < 8; q++)
              gtp[mi][ni][q] = pack2(fsig(acc[mi][ni][2 * q] * rs[mi][2 * q]), fsig(acc[mi][ni][2 * q + 1] * rs[mi][2 * q + 1]));
      }
      zero_acc<2>(acc);
      const u16* Y; int ldy;
      if (n == 0) { Y = (const u16*)(p.ws + OFF_ZA); ldy = ZA_W; }
      else if (n == 1) { Y = (const u16*)(p.ws + OFF_ZB); ldy = ZB_W; }
      else { Y = (const u16*)(p.ws + OFF_YC); ldy = 512; }
      gemm_tile<2>(Y, ldy, W + W_BR + (size_t)n * 1024 * 512, 512, 512, m0, n0, acc, smem);
#pragma unroll
      for (int mi = 0; mi < 2; mi++)
#pragma unroll
        for (int ni = 0; ni < 2; ni++)
#pragma unroll
          for (int r = 0; r < 16; r++) {
            const unsigned g = gtp[mi][ni][r >> 1];
            const float gv = (r & 1) ? bfhi(g) : bflo(g);
            T[(wr * 64 + mi * 32 + crow(r, h2)) * 136 + wc * 64 + ni * 32 + l31] = f2bf(gv * acc[mi][ni][r]);
          }
      __syncthreads();
      {
#pragma unroll 1
        for (int hh = 0; hh < 2; hh++) {
          u32x4 tv[4], ov[4];
#pragma unroll
          for (int i = 0; i < 4; i++) {
            const int idx = TX + 256 * (hh * 4 + i), row = idx >> 4, chn = idx & 15;
            tv[i] = *(const u32x4*)(T + row * 136 + chn * 8);
            ov[i] = (u32x4){0u, 0u, 0u, 0u};
            if (!first) ov[i] = *(const u32x4*)(MG + (size_t)(m0 + row) * 1024 + n0 + chn * 8);
          }
#pragma unroll
          for (int i = 0; i < 4; i++) {
            const int idx = TX + 256 * (hh * 4 + i), row = idx >> 4, chn = idx & 15;
            u32x4 o;
#pragma unroll
            for (int q = 0; q < 4; q++) o[q] = pack2(bflo(tv[i][q]) + bflo(ov[i][q]), bfhi(tv[i][q]) + bfhi(ov[i][q]));
            *(u32x4*)(MG + (size_t)(m0 + row) * 1024 + n0 + chn * 8) = o;
          }
        }
      }
      first = false;
    }
  }
}

DI void phase_resid(const Params& p, const u16* A, int lda, const u16* Bt, int K, const float* xin, float* xout, char* smem) {
  const int TX = tid_opaque();
  const int lane = TX & 63, w = TX >> 6, wr = w >> 1, wc = w & 1, l31 = lane & 31, h2 = lane >> 5;
  const int ntiles = 256 * 8;
  for (int t = blockIdx.x; t < ntiles; t += gridDim.x) {
    int m0, n0; tile_coords(t, 8, m0, n0);
    f32x16 acc[2][2]; zero_acc<2>(acc);
    gemm_tile<2>(A, lda, Bt, K, K, m0, n0, acc, smem);
    float xv[2][2][16];
#pragma unroll
    for (int mi = 0; mi < 2; mi++)
#pragma unroll
      for (int ni = 0; ni < 2; ni++)
#pragma unroll
        for (int r = 0; r < 16; r++) xv[mi][ni][r] = xin[(size_t)(m0 + wr * 64 + mi * 32 + crow(r, h2)) * 1024 + n0 + wc * 64 + ni * 32 + l31];
#pragma unroll
    for (int mi = 0; mi < 2; mi++)
#pragma unroll
      for (int ni = 0; ni < 2; ni++)
#pragma unroll
        for (int r = 0; r < 16; r++) xout[(size_t)(m0 + wr * 64 + mi * 32 + crow(r, h2)) * 1024 + n0 + wc * 64 + ni * 32 + l31] = xv[mi][ni][r] + acc[mi][ni][r];
  }
}

DI void phase_gateup(const Params& p, char* smem) {
  const int TX = tid_opaque();
  const u16* XB = (const u16*)(p.ws + OFF_XB);
  const u16* W = (const u16*)(p.ws + OFF_W) + W_GU;
  const float* rstd = (const float*)(p.ws + OFF_SM + SM_RSTD);
  u16* ACT = (u16*)(p.ws + OFF_ACT);
  const int lane = TX & 63, w = TX >> 6, wr = w >> 1, wc = w & 1, l31 = lane & 31, h2 = lane >> 5;
  const int ntiles = 256 * 44;
  u32x4 pa[2][4], pb[2][4];
  int t = blockIdx.x, m0 = 0, n0 = 0;
  if (t < ntiles) { tile_coords(t, 44, m0, n0); gemm_pref<2>(XB, 1024, W, 1024, m0, n0, pa, pb); }
  for (; t < ntiles; t += gridDim.x) {
    f32x16 acc[2][2]; zero_acc<2>(acc);
    gemm_main<2>(XB, 1024, W, 1024, 1024, m0, n0, acc, smem, pa, pb);
    const int em0 = m0, en0 = n0;
    float rs[2][16];
#pragma unroll
    for (int mi = 0; mi < 2; mi++)
#pragma unroll
      for (int r = 0; r < 16; r++) rs[mi][r] = rstd[em0 + wr * 64 + mi * 32 + crow(r, h2)];
    if (t + (int)gridDim.x < ntiles) { tile_coords(t + gridDim.x, 44, m0, n0); gemm_pref<2>(XB, 1024, W, 1024, m0, n0, pa, pb); }
    u16* T = (u16*)smem;
#pragma unroll
    for (int mi = 0; mi < 2; mi++)
#pragma unroll
      for (int r = 0; r < 16; r++) {
        const float g = acc[mi][0][r] * rs[mi][r], u = acc[mi][1][r] * rs[mi][r];
        T[(wr * 64 + mi * 32 + crow(r, h2)) * 72 + wc * 32 + l31] = f2bf(g * fsig(g) * u);
      }
    __syncthreads();
    {
      u16* dst = ACT + (size_t)em0 * DFF + (en0 >> 7) * 64;
      u32x4 tv[4];
#pragma unroll
      for (int i = 0; i < 4; i++) { const int idx = TX + 256 * i; tv[i] = *(const u32x4*)(T + (idx >> 3) * 72 + (idx & 7) * 8); }
#pragma unroll
      for (int i = 0; i < 4; i++) { const int idx = TX + 256 * i; *(u32x4*)(dst + (size_t)(idx >> 3) * DFF + (idx & 7) * 8) = tv[i]; }
    }
  }
}

DI void phase_ple(const Params& p, char* smem) {
  const int TX = tid_opaque();
  const u16* XB = (const u16*)(p.ws + OFF_XB);
  const u16* PB = (const u16*)(p.ws + OFF_PB);
  const u16* W = (const u16*)(p.ws + OFF_W);
  const float* rstd = (const float*)(p.ws + OFF_SM + SM_RSTD);
  const int lane = TX & 63, w = TX >> 6, wr = w >> 1, wc = w & 1, l31 = lane & 31, h2 = lane >> 5;
  const int ntiles = 256 * 8;
  for (int t = blockIdx.x; t < ntiles; t += gridDim.x) {
    int m0, n0; tile_coords(t, 8, m0, n0);
    f32x16 acc[2][2]; zero_acc<2>(acc);
    gemm_tile<2>(PB, 256, W + W_PP, 256, 256, m0, n0, acc, smem);
    unsigned pp[2][2][8];
#pragma unroll
    for (int mi = 0; mi < 2; mi++)
#pragma unroll
      for (int ni = 0; ni < 2; ni++)
#pragma unroll
        for (int q = 0; q < 8; q++) pp[mi][ni][q] = pack2(acc[mi][ni][2 * q], acc[mi][ni][2 * q + 1]);
    zero_acc<2>(acc);
    gemm_tile<2>(XB, 1024, W + W_PG, 1024, 1024, m0, n0, acc, smem);
#pragma unroll
    for (int mi = 0; mi < 2; mi++) {
      float rs[16], xv[2][16];
#pragma unroll
      for (int r = 0; r < 16; r++) rs[r] = rstd[m0 + wr * 64 + mi * 32 + crow(r, h2)];
#pragma unroll
      for (int ni = 0; ni < 2; ni++)
#pragma unroll
        for (int r = 0; r < 16; r++) xv[ni][r] = p.out[(size_t)(m0 + wr * 64 + mi * 32 + crow(r, h2)) * 1024 + n0 + wc * 64 + ni * 32 + l31];
#pragma unroll
      for (int ni = 0; ni < 2; ni++)
#pragma unroll
        for (int r = 0; r < 16; r++) {
          const unsigned pu = pp[mi][ni][r >> 1];
          const float pv = (r & 1) ? bfhi(pu) : bflo(pu);
          p.out[(size_t)(m0 + wr * 64 + mi * 32 + crow(r, h2)) * 1024 + n0 + wc * 64 + ni * 32 + l31] = xv[ni][r] + pv * fsig(acc[mi][ni][r] * rs[r]);
        }
    }
  }
}

#define XB_TMO      128
#define XB_XCNT(j)  (256  + 64 * (j))
#define XB_XSUB(j)  (1280 + 64 * (j))
#define XB_XGEN(j)  (2304 + 64 * (j))
#define XB_TOP      3328
#define XB_TOPGEN   3392
#define XCD_BAR_WORDS 3456
#define XB_SPIN_CAP (1u << 18)
#define LAS __attribute__((address_space(3)))

__device__ __forceinline__ unsigned xb_ld(unsigned* p)              { return __hip_atomic_load(p, __ATOMIC_RELAXED, __HIP_MEMORY_SCOPE_AGENT); }
__device__ __forceinline__ unsigned xb_add(unsigned* p, unsigned v) { return __hip_atomic_fetch_add(p, v, __ATOMIC_RELAXED, __HIP_MEMORY_SCOPE_AGENT); }
__device__ __forceinline__ unsigned xb_xcc_id() { return (unsigned)__builtin_amdgcn_s_getreg((3 << 11) | 20) & 0xFu; }
#define XB_SPIN(cond, bar) do { unsigned _sp = 0; while (cond) { __builtin_amdgcn_s_sleep(1); \
    if ((++_sp & 255u) == 0u) { if (xb_ld(&(bar)[XB_TMO])) break; if (_sp > XB_SPIN_CAP) { atomicAdd(&(bar)[XB_TMO], 1u); break; } } } } while (0)

struct XcdBarrier {
    unsigned* bar; unsigned x;
    volatile LAS unsigned* st;
};

__device__ __forceinline__ XcdBarrier xcd_barrier_post(unsigned* bar, volatile LAS unsigned* st) {
    XcdBarrier b; b.bar = bar; b.x = xb_xcc_id(); b.st = st;
    if (threadIdx.x == 0) (void)xb_add(&bar[XB_XCNT(b.x)], 1u);
    return b;
}
__device__ __forceinline__ void xcd_barrier_complete(unsigned* bar, unsigned x, unsigned& nloc, unsigned& nx) {
    const unsigned G = gridDim.x * gridDim.y * gridDim.z;
    unsigned sum, cnt, mine, sp = 0u;
    for (;;) {
        sum = 0u; cnt = 0u; mine = 0u;
#pragma unroll
        for (unsigned j = 0; j < 16; ++j) { const unsigned c = xb_ld(&bar[XB_XCNT(j)]); sum += c; cnt += (c > 0u) ? 1u : 0u; mine = (j == x) ? c : mine; }
        if (sum == G) break;
        __builtin_amdgcn_s_sleep(1);
        if ((++sp & 255u) == 0u) { if (xb_ld(&bar[XB_TMO])) break; if (sp > XB_SPIN_CAP) { atomicAdd(&bar[XB_TMO], 1u); break; } }
    }
    nloc = mine > 0u ? mine : 1u; nx = cnt > 0u ? cnt : 1u;
}

__device__ __forceinline__ void xcd_barrier(const XcdBarrier& b) {
    asm volatile("s_waitcnt vmcnt(0)" ::: "memory");
    __syncthreads();
    if (threadIdx.x == 0) {
        unsigned* bar = b.bar;
        __builtin_amdgcn_s_waitcnt(0);
        unsigned nloc = b.st[0], nx = b.st[1];
        if (nloc == 0u) { xcd_barrier_complete(bar, b.x, nloc, nx); b.st[0] = nloc; b.st[1] = nx; }
        const unsigned old = xb_add(&bar[XB_XSUB(b.x)], 1u);
        const unsigned gen = old / nloc;
        if (old + 1u == (gen + 1u) * nloc) {
            __builtin_amdgcn_fence(__ATOMIC_RELEASE, "agent");
            asm volatile("s_waitcnt vmcnt(0)" ::: "memory");
            const unsigned og = xb_add(&bar[XB_TOP], 1u);
            const unsigned tg = og / nx;
            if (og + 1u == (tg + 1u) * nx) xb_add(&bar[XB_TOPGEN], 1u);
            else XB_SPIN(xb_ld(&bar[XB_TOPGEN]) == tg, bar);
            __builtin_amdgcn_fence(__ATOMIC_ACQUIRE, "agent");
            xb_add(&bar[XB_XGEN(b.x)], 1u);
            asm volatile("s_waitcnt vmcnt(0)" ::: "memory");
        } else {
            XB_SPIN(xb_ld(&bar[XB_XGEN(b.x)]) == gen, bar);
            __builtin_amdgcn_fence(__ATOMIC_ACQUIRE, "agent");
            asm volatile("s_waitcnt vmcnt(0)" ::: "memory");
        }
    }
    __syncthreads();
}

template <int L>
DI void run_layer(const Params& p, char* smem, cg::grid_group& grid, const XcdBarrier& xb) {
  const float* xin = (L == 0) ? p.in[0] : p.out;
  phase_convw(p, L);
  phase_prep(p, xin, nullptr);
  if (L == 0) { grid.sync(); if (threadIdx.x == 0) (void)xb_add(&xb.bar[XB_XCNT(xb.x)], 1u); }
  else xcd_barrier(xb);
  phase_inproj(p, L, smem);
  xcd_barrier(xb);
  phase_kmean(p, smem);
  phase_lrprep(p, L);
  xcd_barrier(xb);
  phase_mixers(p, L, smem);
  xcd_barrier(xb);
  if (L == 1) { phase_prep(p, xin, nullptr); xcd_barrier(xb); }
  phase_merge(p, smem);
  xcd_barrier(xb);
  phase_resid(p, (const u16*)(p.ws + OFF_MERGED), 1024, (const u16*)(p.ws + OFF_W) + W_OUT, 1024, xin, p.out, smem);
  xcd_barrier(xb);
  phase_prep(p, p.out, nullptr);
  xcd_barrier(xb);
  phase_gateup(p, smem);
  xcd_barrier(xb);
  phase_resid(p, (const u16*)(p.ws + OFF_ACT), DFF, (const u16*)(p.ws + OFF_W) + W_DN, DFF, p.out, p.out, smem);
  xcd_barrier(xb);
  phase_prep(p, p.out, p.in[1] + (size_t)L * T_TOK * 256);
  xcd_barrier(xb);
  phase_ple(p, smem);
  xcd_barrier(xb);
}

__global__ void __launch_bounds__(NTHR, 2) fwd_megakernel(Params p) {
  cg::grid_group grid = cg::this_grid();
  __shared__ __attribute__((aligned(16))) char smem[SMEM_BYTES];
  __shared__ uint4 xb_words;
  if (threadIdx.x == 0) xb_words = make_uint4(0u, 0u, 0u, 0u);
  __syncthreads();
  XcdBarrier xb; xb.bar = (unsigned*)(p.ws + OFF_SM + SM_BAR); xb.x = xb_xcc_id(); xb.st = (volatile LAS unsigned*)&xb_words;
  if (blockIdx.x == 0) for (int i = threadIdx.x; i < XCD_BAR_WORDS; i += NTHR) xb.bar[i] = 0u;
  run_layer<0>(p, smem, grid, xb);
  run_layer<1>(p, smem, grid, xb);
  phase_final(p);
}

extern "C" void kernel_launch(void* const* d_in, const int* in_sizes, int n_in, void* d_out, int out_size,
                              void* d_ws, size_t ws_size, hipStream_t stream) {
  static int grid_blocks = 0;
  if (!grid_blocks) {
    int dev = 0, cus = 0, per_cu = 0;
    (void)hipGetDevice(&dev);
    (void)hipDeviceGetAttribute(&cus, hipDeviceAttributeMultiprocessorCount, dev);
    (void)hipOccupancyMaxActiveBlocksPerMultiprocessor(&per_cu, fwd_megakernel, NTHR, 0);
    if (per_cu > 2) per_cu = 2;
    if (per_cu < 1) per_cu = 1;
    grid_blocks = cus * per_cu;
  }
  Params p{};
  for (int i = 0; i < 28; i++) p.in[i] = (const float*)d_in[i];
  p.out = (float*)d_out;
  p.ws = (char*)d_ws;
  void* args[] = {&p};
  hipError_t e = hipLaunchCooperativeKernel((void*)fwd_megakernel, dim3(grid_blocks), dim3(NTHR), args, 0, stream);
  if (e != hipSuccess) fprintf(stderr, "cooperative launch failed: %s (grid %d)\n", hipGetErrorString(e), grid_blocks);
}
```

```cpp
#include <hip/hip_runtime.h>
#include <hip/hip_cooperative_groups.h>
#include <cstdio>
#include <cstdint>
namespace cg = cooperative_groups;

#ifndef EN_ATT
#define EN_ATT 1
#endif
#ifndef EN_RET
#define EN_RET 1
#endif
#ifndef EN_RWKV
#define EN_RWKV 1
#endif

typedef unsigned short u16;
using bf16x8 = __attribute__((ext_vector_type(8))) short;
using s16x4  = __attribute__((ext_vector_type(4))) short;
using f32x16 = __attribute__((ext_vector_type(16))) float;
typedef float f2 __attribute__((ext_vector_type(2)));
typedef unsigned u32x4 __attribute__((ext_vector_type(4)));
typedef __bf16 bf2 __attribute__((ext_vector_type(2)));
#define DI __device__ __forceinline__
#define MFMA(a, b, c) __builtin_amdgcn_mfma_f32_32x32x16_bf16((a), (b), (c), 0, 0, 0)

constexpr int T_TOK = 32768, SEQ = 4096, DM = 1024, NBATCH = 8;
constexpr int DFF = 2816;
constexpr int ZA_W = 1536, ZB_W = 2048, ZC_W = 1824;
constexpr int N_INP = 5376;
constexpr int N_INP_PAD = 5504;
constexpr int SMEM_BYTES = 79872;
constexpr int NTHR = 256;

constexpr size_t MiB = 1048576ull;
constexpr size_t OFF_XB = 0;
constexpr size_t OFF_ZA = OFF_XB + 64 * MiB;
constexpr size_t OFF_ZB = OFF_ZA + 96 * MiB;
constexpr size_t OFF_ZC = OFF_ZB + 128 * MiB;
constexpr size_t OFF_YC = OFF_ZC + 114 * MiB;
constexpr size_t OFF_VF = OFF_YC + 32 * MiB;
constexpr size_t OFF_W  = OFF_VF + 32 * MiB;
constexpr size_t OFF_SM = OFF_W + 42 * MiB;
constexpr size_t OFF_MERGED = OFF_ZC;
constexpr size_t OFF_PB     = OFF_ZC + 64 * MiB;
constexpr size_t OFF_ACT    = OFF_ZA;
constexpr size_t OFF_ACTLR  = OFF_XB;
constexpr size_t W_IN  = 0;
constexpr size_t W_G   = W_IN + (size_t)N_INP_PAD * 1024;
constexpr size_t W_BR  = W_G + 3072ull * 1024;
constexpr size_t W_OUT = W_BR + 3ull * 1024 * 512;
constexpr size_t W_GU  = W_OUT + 1024ull * 1024;
constexpr size_t W_DN  = W_GU + 5632ull * 1024;
constexpr size_t W_PG  = W_DN + 1024ull * 2816;
constexpr size_t W_PP  = W_PG + 1024ull * 1024;
constexpr size_t W_W2  = W_PP + 1024ull * 256;
constexpr size_t W_A2  = W_W2 + 512ull * 64;
constexpr size_t W_G2  = W_A2 + 512ull * 64;
constexpr size_t W_V2  = W_G2 + 512ull * 128;
constexpr size_t W_END = W_V2 + 512ull * 32;
static_assert(W_END * 2 <= 42 * MiB, "weights region");
constexpr size_t SM_RSTD = 0;
constexpr size_t SM_KMEAN = SM_RSTD + 4ull * T_TOK;
constexpr size_t SM_COSA = SM_KMEAN + 4ull * 8 * 16 * 8 * 64;
constexpr size_t SM_SINA = SM_COSA + 4ull * 4096 * 8;
constexpr size_t SM_COSB = SM_SINA + 4ull * 4096 * 8;
constexpr size_t SM_SINB = SM_COSB + 4ull * 4096 * 64;
constexpr size_t SM_CNT  = SM_SINB + 4ull * 4096 * 64;
constexpr size_t SM_BAR  = SM_CNT + 256;
constexpr size_t SM_FLG  = SM_BAR + 4 * 3456;
constexpr size_t SM_XCH  = SM_FLG + 128 * 64;
constexpr size_t SM_END  = SM_XCH + 128 * 4 * 32 * 2 * 8;
static_assert(OFF_SM + SM_END <= 512 * MiB, "ws budget");

struct Params {
  const float* in[28];
  float* out;
  char* ws;
};

DI u16 f2bf(float x) { unsigned u = __float_as_uint(x); u += 0x7fffu + ((u >> 16) & 1u); return (u16)(u >> 16); }
DI float bf2f(u16 v) { return __uint_as_float(((unsigned)v) << 16); }
DI unsigned pack2(float a, float b) { f2 v = {a, b}; bf2 r = __builtin_convertvector(v, bf2); return __builtin_bit_cast(unsigned, r); }
DI float bflo(unsigned u) { return __uint_as_float(u << 16); }
DI float bfhi(unsigned u) { return __uint_as_float(u & 0xffff0000u); }
DI int tid_opaque() { int t = threadIdx.x; asm volatile("" : "+v"(t)); return t; }
DI void lds_barrier() { asm volatile("s_waitcnt lgkmcnt(0)\n\ts_barrier" ::: "memory"); }
DI int crow(int reg, int h) { return (reg & 3) + 8 * (reg >> 2) + 4 * h; }
DI float sigmoidf_(float x) { return 1.f / (1.f + __expf(-x)); }
template <int CTRL> DI float dpp_mov(float v) {
  return __builtin_bit_cast(float, __builtin_amdgcn_update_dpp(0, __builtin_bit_cast(int, v), CTRL, 0xF, 0xF, true));
}
DI float red8(float v) {
  v += dpp_mov<0xB1>(v); v += dpp_mov<0x4E>(v); v += dpp_mov<0x141>(v); return v;
}
DI bf16x8 pack8(float a0, float a1, float a2, float a3, float a4, float a5, float a6, float a7) {
  uint4 u = {pack2(a0, a1), pack2(a2, a3), pack2(a4, a5), pack2(a6, a7)};
  return __builtin_bit_cast(bf16x8, u);
}
DI s16x4 tr_read(const u16* p) {
  return __builtin_amdgcn_ds_read_tr16_b64_v4i16((__attribute__((address_space(3))) s16x4*)(p));
}
DI float fast_rcp(float x) { return __builtin_amdgcn_rcpf(x); }
DI float fsig(float x) { return fast_rcp(1.f + __expf(-x)); }
DI float ftanh(float x) { return 1.f - 2.f * fast_rcp(1.f + __expf(2.f * x)); }
DI void unpack8(u32x4 u, float (&o)[8]) {
  o[0] = bflo(u[0]); o[1] = bfhi(u[0]); o[2] = bflo(u[1]); o[3] = bfhi(u[1]);
  o[4] = bflo(u[2]); o[5] = bfhi(u[2]); o[6] = bflo(u[3]); o[7] = bfhi(u[3]);
}
DI bf16x8 cat44(s16x4 lo, s16x4 hi) { return __builtin_shufflevector(lo, hi, 0, 1, 2, 3, 4, 5, 6, 7); }
template <int MI>
DI void zero_acc(f32x16 (&acc)[MI][2]) {
#pragma unroll
  for (int i = 0; i < MI; i++)
#pragma unroll
    for (int j = 0; j < 2; j++)
#pragma unroll
      for (int r = 0; r < 16; r++) acc[i][j][r] = 0.f;
}

#define LDS_PTR(p) ((__attribute__((address_space(3))) void*)(p))
#define GLB_PTR(p) ((const __attribute__((address_space(1))) void*)(p))
template <int MI>
DI void gemm_pref(const u16* __restrict__ A, int lda, const u16* __restrict__ Bt, int ldb, int m0, int n0,
                  u32x4 (&pa)[2][4], u32x4 (&pb)[2][4]) {
  const int tid = tid_opaque();
  const int lrow = tid >> 3, lk = (tid & 7) * 8;
  const u16* ag = A + (size_t)(m0 + lrow) * lda + lk;
  const u16* bg = Bt + (size_t)(n0 + lrow) * ldb + lk;
#pragma unroll
  for (int st = 0; st < 2; st++) {
#pragma unroll
    for (int i = 0; i < 2 * MI; i++) pa[st][i] = *(const u32x4*)(ag + (size_t)st * 64 + (size_t)(32 * i) * lda);
#pragma unroll
    for (int i = 0; i < 4; i++) pb[st][i] = *(const u32x4*)(bg + (size_t)st * 64 + (size_t)(32 * i) * ldb);
  }
}
template <int MI>
DI void gemm_main(const u16* __restrict__ A, int lda, const u16* __restrict__ Bt, int ldb, int K,
                  int m0, int n0, f32x16 (&acc)[MI][2], char* smem, u32x4 (&pa)[2][4], u32x4 (&pb)[2][4]) {
  const int TX = tid_opaque();
  const int tid = TX, lane = tid & 63, w = tid >> 6, wr = w >> 1, wc = w & 1;
  const int l31 = lane & 31, h2 = lane >> 5;
  const int lrow = tid >> 3, lk = (tid & 7) * 8;
  const u16* ag = A + (size_t)(m0 + lrow) * lda + lk;
  const u16* bg = Bt + (size_t)(n0 + lrow) * ldb + lk;
  u16* sm = (u16*)smem;
#define G_LOAD(S, KT) do { const u16* a_ = ag + (size_t)(KT) * 64; const u16* b_ = bg + (size_t)(KT) * 64; \
    _Pragma("unroll") for (int i_ = 0; i_ < 2 * MI; i_++) pa[S][i_] = *(const u32x4*)(a_ + (size_t)(32 * i_) * lda); \
    _Pragma("unroll") for (int i_ = 0; i_ < 4; i_++) pb[S][i_] = *(const u32x4*)(b_ + (size_t)(32 * i_) * ldb); } while (0)
#define S_WRITE(S, BUF) do { u16* d_ = sm + (BUF) * 18432; \
    _Pragma("unroll") for (int i_ = 0; i_ < 2 * MI; i_++) *(u32x4*)(d_ + (lrow + 32 * i_) * 72 + lk) = pa[S][i_]; \
    _Pragma("unroll") for (int i_ = 0; i_ < 4; i_++) *(u32x4*)(d_ + 9216 + (lrow + 32 * i_) * 72 + lk) = pb[S][i_]; } while (0)
#define LDFRAG(KS, FA, FB0, FB1) do { \
      FB0 = *(const bf16x8*)(sB_ + (wc * 64 + l31) * 72 + (KS) * 16 + h2 * 8); \
      FB1 = *(const bf16x8*)(sB_ + (wc * 64 + 32 + l31) * 72 + (KS) * 16 + h2 * 8); \
      _Pragma("unroll") for (int mi = 0; mi < MI; mi++) FA[mi] = *(const bf16x8*)(sA_ + (wr * 32 * MI + mi * 32 + l31) * 72 + (KS) * 16 + h2 * 8); } while (0)
#define DOMMA(FA, FB0, FB1) do { _Pragma("unroll") for (int mi = 0; mi < MI; mi++) { \
      acc[mi][0] = MFMA(FA[mi], FB0, acc[mi][0]); acc[mi][1] = MFMA(FA[mi], FB1, acc[mi][1]); } } while (0)
#define COMPUTE(BUF) do { const u16* sA_ = sm + (BUF) * 18432; const u16* sB_ = sA_ + 9216; \
    bf16x8 fa0[MI], fa1[MI], fb00, fb01, fb10, fb11; \
    LDFRAG(0, fa0, fb00, fb01); \
    LDFRAG(1, fa1, fb10, fb11); \
    DOMMA(fa0, fb00, fb01); \
    LDFRAG(2, fa0, fb00, fb01); \
    DOMMA(fa1, fb10, fb11); \
    LDFRAG(3, fa1, fb10, fb11); \
    DOMMA(fa0, fb00, fb01); \
    DOMMA(fa1, fb10, fb11); } while (0)
  const int nk = K >> 6;
  __syncthreads();
  S_WRITE(0, 0);
  __syncthreads();
  for (int kt = 0; kt < nk; kt += 2) {
    if (kt + 2 < nk) G_LOAD(0, kt + 2);
    COMPUTE(0);
    S_WRITE(1, 1);
    __syncthreads();
    if (kt + 3 < nk) G_LOAD(1, kt + 3);
    COMPUTE(1);
    if (kt + 2 < nk) S_WRITE(0, 0);
    __syncthreads();
  }
#undef G_LOAD
#undef S_WRITE
#undef COMPUTE
#undef LDFRAG
#undef DOMMA
}
template <int MI>
DI void gemm_tile(const u16* __restrict__ A, int lda, const u16* __restrict__ Bt, int ldb, int K,
                  int m0, int n0, f32x16 (&acc)[MI][2], char* smem) {
  u32x4 pa[2][4], pb[2][4];
  gemm_pref<MI>(A, lda, Bt, ldb, m0, n0, pa, pb);
  gemm_main<MI>(A, lda, Bt, ldb, K, m0, n0, acc, smem, pa, pb);
}

DI void tile_coords(int t, int nN, int& m0, int& n0) {
  const int GM = 32;
  int per = GM * nN;
  int g = t / per, r = t - g * per;
  int n = r / GM, m = g * GM + (r - n * GM);
  m0 = m * 128; n0 = n * 128;
}

DI void conv_job(const float* __restrict__ src, int lds, int scol0, int K, int N, const float* __restrict__ gain,
                 u16* __restrict__ dst, int perm_gu, int gsz, int gid) {
  const int kg = K >> 3;
  const long total = (long)N * kg;
  constexpr int U = 4;
  for (long it = gid; it < total; it += (long)U * gsz) {
    float v[U][8]; int nn[U], kk0[U]; bool ok[U];
#pragma unroll
    for (int u = 0; u < U; u++) {
      const long itu = it + (long)u * gsz;
      ok[u] = itu < total;
      const long iq = ok[u] ? itu : it;
      const int n = (int)(iq % N), k0 = (int)(iq / N) * 8;
      nn[u] = n; kk0[u] = k0;
      int sc;
      if (perm_gu) { int blk = n >> 6, r = n & 63; int j = blk * 32 + (r & 31); sc = (r < 32) ? j : (DFF + j); }
      else sc = scol0 + n;
#pragma unroll
      for (int i = 0; i < 8; i++) v[u][i] = src[(size_t)(k0 + i) * lds + sc];
    }
    if (gain) {
#pragma unroll
      for (int u = 0; u < U; u++)
#pragma unroll
        for (int i = 0; i < 8; i++) v[u][i] *= gain[kk0[u] + i];
    }
#pragma unroll
    for (int u = 0; u < U; u++)
      if (ok[u]) *(uint4*)(dst + (size_t)nn[u] * K + kk0[u]) = (uint4){pack2(v[u][0], v[u][1]), pack2(v[u][2], v[u][3]), pack2(v[u][4], v[u][5]), pack2(v[u][6], v[u][7])};
  }
}

DI void phase_convw(const Params& p, int l) {
  const int TX = tid_opaque();
  const int gsz = gridDim.x * NTHR, gid = blockIdx.x * NTHR + TX;
  u16* W = (u16*)(p.ws + OFF_W);
  const float* w_in = p.in[3] + (size_t)l * 1024 * 8448;
  const float* gmix = p.in[2] + l * 1024;
  conv_job(w_in, 8448, 0, 1024, N_INP, gmix, W + W_IN, 0, gsz, gid);
  if (l == 1) conv_job(p.in[15], 32, 0, 1024, 32, gmix, W + W_IN + (size_t)N_INP * 1024, 0, gsz, gid);
  {
    int r0 = (l == 1) ? N_INP + 32 : N_INP;
    long total = (long)(N_INP_PAD - r0) * 128;
    uint4 z = {0, 0, 0, 0};
    for (long it = gid; it < total; it += gsz) *(uint4*)(W + W_IN + (size_t)r0 * 1024 + it * 8) = z;
  }
  conv_job(w_in, 8448, N_INP, 1024, 3072, gmix, W + W_G, 0, gsz, gid);
  for (int n = 0; n < 3; n++)
    conv_job(p.in[19] + ((size_t)l * 3 + n) * 512 * 1024, 1024, 0, 512, 1024, nullptr, W + W_BR + (size_t)n * 1024 * 512, 0, gsz, gid);
  conv_job(p.in[20] + (size_t)l * 1024 * 1024, 1024, 0, 1024, 1024, nullptr, W + W_OUT, 0, gsz, gid);
  conv_job(p.in[22] + (size_t)l * 1024 * 5632, 5632, 0, 1024, 5632, p.in[21] + l * 1024, W + W_GU, 1, gsz, gid);
  conv_job(p.in[23] + (size_t)l * 2816 * 1024, 1024, 0, 2816, 1024, nullptr, W + W_DN, 0, gsz, gid);
  conv_job(p.in[25] + (size_t)l * 1024 * 1024, 1024, 0, 1024, 1024, p.in[24] + l * 1024, W + W_PG, 0, gsz, gid);
  conv_job(p.in[26] + (size_t)l * 256 * 1024, 1024, 0, 256, 1024, nullptr, W + W_PP, 0, gsz, gid);
  conv_job(p.in[6] + (size_t)l * 64 * 512, 512, 0, 64, 512, nullptr, W + W_W2, 0, gsz, gid);
  conv_job(p.in[8] + (size_t)l * 64 * 512, 512, 0, 64, 512, nullptr, W + W_A2, 0, gsz, gid);
  conv_job(p.in[9] + (size_t)l * 128 * 512, 512, 0, 128, 512, nullptr, W + W_G2, 0, gsz, gid);
  if (l == 1) conv_job(p.in[18], 512, 0, 32, 512, nullptr, W + W_V2, 0, gsz, gid);
  float* kmean = (float*)(p.ws + OFF_SM + SM_KMEAN);
  for (int i = gid; i < 8 * 16 * 8 * 64; i += gsz) kmean[i] = 0.f;
  if (gid < 16) ((int*)(p.ws + OFF_SM + SM_CNT))[gid] = 0;
  for (int i = gid; i < 128 * 4 * 32 * 4; i += gsz) ((unsigned*)(p.ws + OFF_SM + SM_XCH))[i] = 0u;
  if (l == 0) {
    float* ca = (float*)(p.ws + OFF_SM + SM_COSA); float* sa = (float*)(p.ws + OFF_SM + SM_SINA);
    float* cb = (float*)(p.ws + OFF_SM + SM_COSB); float* sb = (float*)(p.ws + OFF_SM + SM_SINB);
    for (int i = gid; i < 4096 * 8; i += gsz) {
      int pos = i >> 3, j = i & 7;
      float inv = 1.0f / powf(500000.0f, (float)(2 * j) / 16.0f);
      float ang = (float)pos * inv;
      ca[i] = cosf(ang); sa[i] = sinf(ang);
    }
    for (int i = gid; i < 4096 * 64; i += gsz) {
      int pos = i >> 6, j = i & 63;
      float inv = 1.0f / powf(10000.0f, (float)j / 63.0f);
      float ang = (float)pos * inv;
      cb[i] = cosf(ang); sb[i] = sinf(ang);
    }
  }
}

DI void phase_prep(const Params& p, const float* __restrict__ x, const float* __restrict__ pl) {
  const int TX = tid_opaque();
  const int lane = TX & 63;
  const int wid = blockIdx.x * (NTHR / 64) + (TX >> 6), nw = gridDim.x * (NTHR / 64);
  u16* XB = (u16*)(p.ws + OFF_XB);
  float* rstd = (float*)(p.ws + OFF_SM + SM_RSTD);
  for (int row = wid; row < T_TOK; row += nw) {
    const float4* xr = (const float4*)(x + (size_t)row * 1024);
    float ss = 0.f;
    float4 xv4[4];
#pragma unroll
    for (int i = 0; i < 4; i++) xv4[i] = xr[lane + 64 * i];
    float4 pv4 = {0.f, 0.f, 0.f, 0.f};
    if (pl) pv4 = ((const float4*)(pl + (size_t)row * 256))[lane];
#pragma unroll
    for (int i = 0; i < 4; i++) {
      const float4 v = xv4[i];
      ss += v.x * v.x + v.y * v.y + v.z * v.z + v.w * v.w;
      uint2 u = {pack2(v.x, v.y), pack2(v.z, v.w)};
      *(uint2*)(XB + (size_t)row * 1024 + (lane + 64 * i) * 4) = u;
    }
#pragma unroll
    for (int o = 32; o > 0; o >>= 1) ss += __shfl_xor(ss, o, 64);
    if (lane == 0) rstd[row] = rsqrtf(ss * (1.0f / 1024.0f) + 1e-6f);
    if (pl) {
      const float4 v = pv4;
      uint2 u = {pack2(v.x, v.y), pack2(v.z, v.w)};
      *(uint2*)((u16*)(p.ws + OFF_PB) + (size_t)row * 256 + lane * 4) = u;
    }
  }
}

DI void phase_final(const Params& p) {
  const int TX = tid_opaque();
  const int lane = TX & 63;
  const int wid = blockIdx.x * (NTHR / 64) + (TX >> 6), nw = gridDim.x * (NTHR / 64);
  const float4* g4 = (const float4*)p.in[27];
  for (int row = wid; row < T_TOK; row += nw) {
    float4* xr = (float4*)(p.out + (size_t)row * 1024);
    float4 v[4];
    float ss = 0.f;
#pragma unroll
    for (int i = 0; i < 4; i++) {
      v[i] = xr[lane + 64 * i];
      ss += v[i].x * v[i].x + v[i].y * v[i].y + v[i].z * v[i].z + v[i].w * v[i].w;
    }
#pragma unroll
    for (int o = 32; o > 0; o >>= 1) ss += __shfl_xor(ss, o, 64);
    float r = rsqrtf(ss * (1.0f / 1024.0f) + 1e-6f);
#pragma unroll
    for (int i = 0; i < 4; i++) {
      float4 g = g4[lane + 64 * i];
      float4 o = {v[i].x * r * g.x, v[i].y * r * g.y, v[i].z * r * g.z, v[i].w * r * g.w};
      xr[lane + 64 * i] = o;
    }
  }
}

DI void phase_inproj(const Params& p, int l, char* smem) {
  const int TX = tid_opaque();
  const u16* XB = (const u16*)(p.ws + OFF_XB);
  const u16* W = (const u16*)(p.ws + OFF_W) + W_IN;
  const float* rstd = (const float*)(p.ws + OFF_SM + SM_RSTD);
  const float* ca = (const float*)(p.ws + OFF_SM + SM_COSA); const float* sa = (const float*)(p.ws + OFF_SM + SM_SINA);
  const float* cb = (const float*)(p.ws + OFF_SM + SM_COSB); const float* sb = (const float*)(p.ws + OFF_SM + SM_SINB);
  u16* ZA = (u16*)(p.ws + OFF_ZA); u16* ZB = (u16*)(p.ws + OFF_ZB); u16* ZC = (u16*)(p.ws + OFF_ZC);
  const int nvalid = (l == 1) ? N_INP + 32 : N_INP;
  const int nN = (l == 1) ? 43 : 42;
  const int ntiles = 256 * nN;
  const int lane = TX & 63, w = TX >> 6, wr = w >> 1, wc = w & 1, l31 = lane & 31, h2 = lane >> 5;
  u32x4 pa[2][4], pb[2][4];
  int t = blockIdx.x, m0 = 0, n0 = 0;
  if (t < ntiles) { tile_coords(t, nN, m0, n0); gemm_pref<2>(XB, 1024, W, 1024, m0, n0, pa, pb); }
  for (; t < ntiles; t += gridDim.x) {
    f32x16 acc[2][2]; zero_acc<2>(acc);
    gemm_main<2>(XB, 1024, W, 1024, 1024, m0, n0, acc, smem, pa, pb);
    const int em0 = m0, en0 = n0;
    float rs[2][16];
#pragma unroll
    for (int mi = 0; mi < 2; mi++)
#pragma unroll
      for (int r = 0; r < 16; r++) rs[mi][r] = rstd[em0 + wr * 64 + mi * 32 + crow(r, h2)];
    if (t + (int)gridDim.x < ntiles) { tile_coords(t + gridDim.x, nN, m0, n0); gemm_pref<2>(XB, 1024, W, 1024, m0, n0, pa, pb); }
    u16* T = (u16*)smem;
#pragma unroll
    for (int ni = 0; ni < 2; ni++) {
      const int cbase = en0 + wc * 64 + ni * 32;
      if (cbase >= nvalid) continue;
      const int c = cbase + l31;
#pragma unroll
      for (int mi = 0; mi < 2; mi++) {
        const int rbase = em0 + wr * 64 + mi * 32;
        const int lrb = wr * 64 + mi * 32, lc = wc * 64 + ni * 32 + l31;
        if (cbase < 1024) {
          const int d = c & 63;
          const float invf = exp2f(-(float)(d & 7) * (18.931568569324174f / 8.0f));
          float cs[16], sn[16];
#pragma unroll
          for (int r = 0; r < 16; r++) {
            const float ang = (float)((rbase + crow(r, h2)) & (SEQ - 1)) * invf;
            float rev = ang * 0.15915494309189535f; rev = rev - floorf(rev);
            cs[r] = __builtin_amdgcn_cosf(rev); sn[r] = __builtin_amdgcn_sinf(rev);
          }
#pragma unroll
          for (int r = 0; r < 16; r++) {
            float v = acc[mi][ni][r] * rs[mi][r];
            float pv = __shfl_xor(v, 8, 64);
            if (d < 16) v = (d < 8) ? (v * cs[r] - pv * sn[r]) : (pv * sn[r] + v * cs[r]);
            if (cbase < 512) v *= 0.125f;
            T[(lrb + crow(r, h2)) * 136 + lc] = f2bf(v);
          }
        } else if (cbase < 1536) {
#pragma unroll
          for (int r = 0; r < 16; r++) T[(lrb + crow(r, h2)) * 136 + lc] = f2bf(acc[mi][ni][r] * rs[mi][r]);
        } else if (cbase < 2560) {
          const int cc = c - 1536;
          const int i2 = (cc & 127) >> 1;
          const float invf = exp2f(-(float)i2 * (13.287712379549449f / 63.0f));
          float cs[16], sn[16];
#pragma unroll
          for (int r = 0; r < 16; r++) {
            const float ang = (float)((rbase + crow(r, h2)) & (SEQ - 1)) * invf;
            float rev = ang * 0.15915494309189535f; rev = rev - floorf(rev);
            cs[r] = __builtin_amdgcn_cosf(rev); sn[r] = __builtin_amdgcn_sinf(rev);
          }
#pragma unroll
          for (int r = 0; r < 16; r++) {
            float v = acc[mi][ni][r] * rs[mi][r];
            float pv = __shfl_xor(v, 1, 64);
            v = (cc & 1) ? (pv * sn[r] + v * cs[r]) : (v * cs[r] - pv * sn[r]);
            if (cbase >= 2048) v *= 0.08838834764831845f;
            T[(lrb + crow(r, h2)) * 136 + lc] = f2bf(v);
          }
        } else if (cbase < 3584) {
#pragma unroll
          for (int r = 0; r < 16; r++) T[(lrb + crow(r, h2)) * 136 + lc] = f2bf(acc[mi][ni][r] * rs[mi][r]);
        } else {
#pragma unroll
          for (int r = 0; r < 16; r++) T[(lrb + crow(r, h2)) * 136 + lc] = f2bf(acc[mi][ni][r] * rs[mi][r]);
        }
      }
    }
    __syncthreads();
    {
      u16* dst; int pitch;
      if (en0 < 1536) { dst = ZA + en0; pitch = ZA_W; }
      else if (en0 < 3584) { dst = ZB + (en0 - 1536); pitch = ZB_W; }
      else { dst = ZC + (en0 - 3584); pitch = ZC_W; }
      const int vch = min(128, nvalid - en0) >> 3;
      u32x4 tv[8];
#pragma unroll
      for (int i = 0; i < 8; i++) { const int idx = TX + 256 * i; tv[i] = *(const u32x4*)(T + (idx >> 4) * 136 + (idx & 15) * 8); }
#pragma unroll
      for (int i = 0; i < 8; i++) {
        const int idx = TX + 256 * i, row = idx >> 4, chn = idx & 15;
        if (chn < vch) *(u32x4*)(dst + (size_t)(em0 + row) * pitch + chn * 8) = tv[i];
      }
    }
  }
}

DI void phase_kmean(const Params& p, char* smem) {
  const int TX = tid_opaque();
  const u16* ZA = (const u16*)(p.ws + OFF_ZA);
  float* kmean = (float*)(p.ws + OFF_SM + SM_KMEAN);
  float* red = (float*)smem;
  const int d = TX & 63, jg = TX >> 6;
  for (int it = blockIdx.x; it < 8 * 16 * 8; it += gridDim.x) {
    int h = it & 7, n = (it >> 3) & 15, b = it >> 7;
    const u16* base = ZA + ((size_t)(b * SEQ + n * 256 + jg * 64)) * ZA_W + 512 + h * 64 + d;
    float s = 0.f;
    for (int j = 0; j < 64; j++) s += bf2f(base[(size_t)j * ZA_W]);
    __syncthreads();
    red[jg * 64 + d] = s;
    __syncthreads();
    if (jg == 0) kmean[((b * 16 + n) * 8 + h) * 64 + d] = (red[d] + red[64 + d] + red[128 + d] + red[192 + d]) * (1.0f / 256.0f);
  }
}

DI void phase_lrprep(const Params& p, int l) {
  const int TX = tid_opaque();
  const u16* ZC = (const u16*)(p.ws + OFF_ZC);
  u16* ALR = (l == 0) ? (u16*)p.out : (u16*)(p.ws + OFF_ACTLR);
  const float* mu = p.in[4] + l * 1792 + 1536;
  const float* vmu = p.in[16];
  const int gsz = gridDim.x * NTHR, gid = blockIdx.x * NTHR + TX;
  for (int it = gid; it < T_TOK * 36; it += gsz) {
    const int row = it / 36, jg = it - row * 36, j0 = jg * 8;
    float out[8];
    if (j0 >= 256 && l == 0) {
#pragma unroll
      for (int e = 0; e < 8; e++) out[e] = 0.f;
    } else {
      const int col = (j0 < 256) ? (1536 + j0) : (1792 + (j0 - 256));
      const float* mup = (j0 < 256) ? (mu + j0) : (vmu + (j0 - 256));
      u32x4 cu = *(const u32x4*)(ZC + (size_t)row * ZC_W + col);
      u32x4 pu = {0u, 0u, 0u, 0u};
      if ((row & (SEQ - 1)) > 0) pu = *(const u32x4*)(ZC + (size_t)(row - 1) * ZC_W + col);
      float cv[8], pv[8];
      unpack8(cu, cv); unpack8(pu, pv);
#pragma unroll
      for (int e = 0; e < 8; e++) {
        float z = cv[e] + (pv[e] - cv[e]) * mup[e];
        if (j0 < 64) z = ftanh(z);
        else if (j0 >= 128 && j0 < 256) z = fsig(z);
        out[e] = z;
      }
    }
    u32x4 u = {pack2(out[0], out[1]), pack2(out[2], out[3]), pack2(out[4], out[5]), pack2(out[6], out[7])};
    *(u32x4*)(ALR + (size_t)row * 288 + j0) = u;
  }
}

DI void attn_item(const Params& p, int b, int h, int qt, char* smem) {
  const int TX = tid_opaque();
  u16* ZA = (u16*)(p.ws + OFF_ZA);
  const float* kmean = (const float*)(p.ws + OFF_SM + SM_KMEAN);
  const int tid = TX, lane = tid & 63, w = tid >> 6, l31 = lane & 31, h2 = lane >> 5;
  const int qblk = qt >> 1, r0 = (qt & 1) * 128;
  u16* sm = (u16*)smem;
  float* km = (float*)(smem + 36864);
  unsigned* uni = (unsigned*)(smem + 40960);
  __syncthreads();
  for (int i = tid; i < qblk * 64; i += NTHR) {
    int n = i >> 6, d = i & 63;
    km[i] = kmean[((b * 16 + n) * 8 + h) * 64 + d];
  }
  if (tid == 0) *uni = 0u;
  const size_t rowbase = (size_t)b * SEQ;
  const int qrow = qblk * 256 + r0 + w * 32 + l31;
  bf16x8 qf[4];
#pragma unroll
  for (int s = 0; s < 4; s++) qf[s] = *(const bf16x8*)(ZA + (rowbase + qrow) * ZA_W + h * 64 + 16 * s + 8 * h2);
  __syncthreads();
  unsigned selmask = 0;
  {
    float qv[32];
#pragma unroll
    for (int s = 0; s < 4; s++)
#pragma unroll
      for (int j = 0; j < 8; j++) qv[s * 8 + j] = bf2f((u16)qf[s][j]);
    float g[15];
#pragma unroll
    for (int n = 0; n < 15; n++) {
      float a = 0.f;
      if (n < qblk) {
#pragma unroll
        for (int s = 0; s < 4; s++) {
          const float4* kp = (const float4*)(km + n * 64 + 16 * s + 8 * h2);
          float4 k0 = kp[0], k1 = kp[1];
          a += qv[s * 8 + 0] * k0.x + qv[s * 8 + 1] * k0.y + qv[s * 8 + 2] * k0.z + qv[s * 8 + 3] * k0.w
             + qv[s * 8 + 4] * k1.x + qv[s * 8 + 5] * k1.y + qv[s * 8 + 6] * k1.z + qv[s * 8 + 7] * k1.w;
        }
      }
      a += __shfl_xor(a, 32, 64);
      g[n] = (n < qblk) ? a : -INFINITY;
    }
#pragma unroll
    for (int pass = 0; pass < 3; pass++) {
      float best = -INFINITY; int bi = -1;
#pragma unroll
      for (int n = 0; n < 15; n++) {
        bool avail = !((selmask >> n) & 1u);
        if (avail && g[n] > best) { best = g[n]; bi = n; }
      }
      if (bi >= 0) selmask |= (1u << bi);
    }
  }
  {
    unsigned wu = 0;
#pragma unroll
    for (int n = 0; n < 15; n++) { if (__ballot((selmask >> n) & 1u) != 0ull) wu |= (1u << n); }
    if (lane == 0) atomicOr(uni, wu);
  }
  __syncthreads();
  const unsigned ublocks = *uni;
  unsigned wunion = 0;
#pragma unroll
  for (int n = 0; n < 15; n++) { if (__ballot((selmask >> n) & 1u) != 0ull) wunion |= (1u << n); }

  f32x16 o[2];
#pragma unroll
  for (int r = 0; r < 16; r++) { o[0][r] = 0.f; o[1][r] = 0.f; }
  float m_run = -INFINITY, l_run = 0.f;
  const float L2E = 1.4426950408889634f;

  const int own_tiles = (r0 + 128) >> 6;
  int cur_n = -1, cur_j = 0;
  auto advance = [&](int& n, int& j) {
    if (n >= 0 && n <= qblk) {
      int nt = (n == qblk) ? own_tiles : 4;
      if (j + 1 < nt) { j++; return; }
    }
    j = 0;
    int nn = n + 1;
    while (nn < qblk && !((ublocks >> nn) & 1u)) nn++;
    n = nn;
  };
  advance(cur_n, cur_j);
  const int lrow = tid >> 3, lk = (tid & 7) * 8;
  u32x4 rk0, rk1, rv0, rv1;
  auto gload = [&](int n, int j) {
    const u16* kb = ZA + (rowbase + n * 256 + j * 64 + lrow) * ZA_W + 512 + h * 64 + lk;
    rk0 = *(const u32x4*)(kb); rk1 = *(const u32x4*)(kb + (size_t)32 * ZA_W);
    rv0 = *(const u32x4*)(kb + 512); rv1 = *(const u32x4*)(kb + (size_t)32 * ZA_W + 512);
  };
  auto swrite = [&](int st) {
    u16* dk = sm + st * 9216;
    *(u32x4*)(dk + lrow * 72 + lk) = rk0; *(u32x4*)(dk + (lrow + 32) * 72 + lk) = rk1;
    *(u32x4*)(dk + 4608 + lrow * 72 + lk) = rv0; *(u32x4*)(dk + 4608 + (lrow + 32) * 72 + lk) = rv1;
  };
  gload(cur_n, cur_j);
  swrite(0);
  __syncthreads();
  int st = 0;
  while (cur_n <= qblk) {
    int nx_n = cur_n, nx_j = cur_j;
    advance(nx_n, nx_j);
    const bool more = (nx_n <= qblk);
    if (more) gload(nx_n, nx_j);
    const u16* sK = sm + st * 9216;
    const u16* sV = sK + 4608;
    const bool own = (cur_n == qblk);
    bool active = own ? (cur_j * 64 <= r0 + w * 32 + 31) : (((wunion >> cur_n) & 1u) != 0u);
    if (active) {
      f32x16 sc[2];
#pragma unroll
      for (int mt = 0; mt < 2; mt++) {
#pragma unroll
        for (int r = 0; r < 16; r++) sc[mt][r] = 0.f;
#pragma unroll
        for (int s = 0; s < 4; s++) {
          bf16x8 a = *(const bf16x8*)(sK + (mt * 32 + l31) * 72 + 16 * s + 8 * h2);
          sc[mt] = MFMA(a, qf[s], sc[mt]);
        }
      }
      const bool selq = own ? true : (((selmask >> cur_n) & 1u) != 0u);
      const float bias = selq ? 0.f : -INFINITY;
      const int qi = r0 + w * 32 + l31;
      const bool diag = own && (cur_j * 64 + 63 > r0 + w * 32);
      float tmax = -INFINITY;
      if (diag) {
#pragma unroll
        for (int mt = 0; mt < 2; mt++)
#pragma unroll
          for (int r = 0; r < 16; r++) {
            const bool keep = (cur_j * 64 + mt * 32 + crow(r, h2)) <= qi;
            const float v = keep ? sc[mt][r] : -INFINITY;
            sc[mt][r] = v;
            tmax = fmaxf(tmax, v);
          }
      } else {
#pragma unroll
        for (int mt = 0; mt < 2; mt++)
#pragma unroll
          for (int r = 0; r < 16; r++) { const float v = sc[mt][r] + bias; sc[mt][r] = v; tmax = fmaxf(tmax, v); }
      }
      tmax = fmaxf(tmax, __shfl_xor(tmax, 32, 64)) * L2E;
      float m_new = fmaxf(m_run, tmax);
      float m_use = (m_new == -INFINITY) ? 0.f : m_new;
      float alpha = __builtin_amdgcn_exp2f(m_run - m_use);
      m_run = m_new;
      float psum = 0.f;
#pragma unroll
      for (int mt = 0; mt < 2; mt++)
#pragma unroll
        for (int r = 0; r < 16; r++) { float pe = __builtin_amdgcn_exp2f(fmaf(sc[mt][r], L2E, -m_use)); sc[mt][r] = pe; psum += pe; }
      l_run = l_run * alpha + psum;
#pragma unroll
      for (int r = 0; r < 16; r++) { o[0][r] *= alpha; o[1][r] *= alpha; }
      const int q4 = (lane & 15) >> 2, p4 = lane & 3, gsel = (lane >> 4) & 1;
#pragma unroll
      for (int mt = 0; mt < 2; mt++) {
#pragma unroll
        for (int s2 = 0; s2 < 2; s2++) {
          bf16x8 pf = pack8(sc[mt][8 * s2 + 0], sc[mt][8 * s2 + 1], sc[mt][8 * s2 + 2], sc[mt][8 * s2 + 3],
                            sc[mt][8 * s2 + 4], sc[mt][8 * s2 + 5], sc[mt][8 * s2 + 6], sc[mt][8 * s2 + 7]);
          const int key0 = mt * 32 + 16 * s2 + 4 * h2 + q4;
#pragma unroll
          for (int dt = 0; dt < 2; dt++) {
            s16x4 lo = tr_read(sV + key0 * 72 + dt * 32 + 16 * gsel + 4 * p4);
            s16x4 hi = tr_read(sV + (key0 + 8) * 72 + dt * 32 + 16 * gsel + 4 * p4);
            o[dt] = MFMA(cat44(lo, hi), pf, o[dt]);
          }
        }
      }
    }
    if (more) swrite(st ^ 1);
    __syncthreads();
    st ^= 1;
    cur_n = nx_n; cur_j = nx_j;
  }
  float l_tot = l_run + __shfl_xor(l_run, 32, 64);
  float inv = 1.f / l_tot;
  u16* yo = ZA + (rowbase + qrow) * ZA_W + h * 64;
#pragma unroll
  for (int dt = 0; dt < 2; dt++)
#pragma unroll
    for (int g = 0; g < 4; g++) {
      uint2 u = {pack2(o[dt][4 * g] * inv, o[dt][4 * g + 1] * inv), pack2(o[dt][4 * g + 2] * inv, o[dt][4 * g + 3] * inv)};
      *(uint2*)(yo + dt * 32 + 8 * g + 4 * h2) = u;
    }
}

DI void retention_block(const Params& p, int b, int h, char* smem) {
  const int TX = tid_opaque();
  u16* ZB = (u16*)(p.ws + OFF_ZB);
  const int tid = TX, lane = tid & 63, w = tid >> 6, l31 = lane & 31, h2 = lane >> 5;
  const int qt = w & 1, eh = w >> 1;
  u16* sK = (u16*)smem;
  u16* sV = sK + 64 * 136;
  u16* sR = sV + 64 * 136;
  float* exch = (float*)(smem + (64 * 136 * 2 + 128 * 136) * 2);
  const float gamma = 1.0f - exp2f(-5.0f - (float)h);
  const float lg = log2f(gamma);
  const float g64 = exp2f(lg * 64.f);
  __syncthreads();
  for (int i = tid; i < 128 * 136 / 2; i += NTHR) ((unsigned*)sR)[i] = 0u;
  f32x16 racc[4];
#pragma unroll
  for (int dt = 0; dt < 4; dt++)
#pragma unroll
    for (int r = 0; r < 16; r++) racc[dt][r] = 0.f;
  const int q4 = (lane & 15) >> 2, p4 = lane & 3, gsel = (lane >> 4) & 1;
  const int lrow = tid >> 4, lc = (tid & 15) * 8;
  for (int n = 0; n < SEQ / 64; n++) {
    const size_t rb = (size_t)b * SEQ + n * 64;
#pragma unroll
    for (int i = 0; i < 4; i++) {
      int j = lrow + 16 * i;
      const u16* src = ZB + (rb + j) * ZB_W + 512 + h * 128 + lc;
      uint4 kk = *(const uint4*)src;
      uint4 vv = *(const uint4*)(src + 512);
      float z = exp2f(lg * (float)(63 - j));
      uint4 ks = {pack2(bflo(kk.x) * z, bfhi(kk.x) * z), pack2(bflo(kk.y) * z, bfhi(kk.y) * z),
                  pack2(bflo(kk.z) * z, bfhi(kk.z) * z), pack2(bflo(kk.w) * z, bfhi(kk.w) * z)};
      *(uint4*)(sK + j * 136 + lc) = ks;
      *(uint4*)(sV + j * 136 + lc) = vv;
    }
    const int qi = 32 * qt + l31;
    bf16x8 qf[8];
#pragma unroll
    for (int s = 0; s < 8; s++) qf[s] = *(const bf16x8*)(ZB + (rb + qi) * ZB_W + h * 128 + 16 * s + 8 * h2);
    __syncthreads();
    f32x16 acc[2];
#pragma unroll
    for (int et = 0; et < 2; et++) {
#pragma unroll
      for (int r = 0; r < 16; r++) acc[et][r] = 0.f;
#pragma unroll
      for (int s = 0; s < 8; s++) {
        bf16x8 a = *(const bf16x8*)(sR + (32 * (2 * eh + et) + l31) * 136 + 16 * s + 8 * h2);
        acc[et] = MFMA(a, qf[s], acc[et]);
      }
#pragma unroll
      for (int r = 0; r < 16; r++) acc[et][r] *= g64;
    }
    for (int kt = 0; kt <= qt; kt++) {
      f32x16 sc;
#pragma unroll
      for (int r = 0; r < 16; r++) sc[r] = 0.f;
#pragma unroll
      for (int s = 0; s < 8; s++) {
        bf16x8 a = *(const bf16x8*)(sK + (32 * kt + l31) * 136 + 16 * s + 8 * h2);
        sc = MFMA(a, qf[s], sc);
      }
      if (kt == qt) {
#pragma unroll
        for (int r = 0; r < 16; r++) if (crow(r, h2) > l31) sc[r] = 0.f;
      }
#pragma unroll
      for (int s2 = 0; s2 < 2; s2++) {
        bf16x8 pf = pack8(sc[8 * s2 + 0], sc[8 * s2 + 1], sc[8 * s2 + 2], sc[8 * s2 + 3],
                          sc[8 * s2 + 4], sc[8 * s2 + 5], sc[8 * s2 + 6], sc[8 * s2 + 7]);
        const int key0 = 32 * kt + 16 * s2 + 4 * h2 + q4;
#pragma unroll
        for (int et = 0; et < 2; et++) {
          s16x4 lo = tr_read(sV + key0 * 136 + 32 * (2 * eh + et) + 16 * gsel + 4 * p4);
          s16x4 hi = tr_read(sV + (key0 + 8) * 136 + 32 * (2 * eh + et) + 16 * gsel + 4 * p4);
          acc[et] = MFMA(cat44(lo, hi), pf, acc[et]);
        }
      }
    }
    const float fi = exp2f(lg * (float)(qi - 63));
    float s1 = 0.f, s2s = 0.f;
#pragma unroll
    for (int et = 0; et < 2; et++)
#pragma unroll
      for (int r = 0; r < 16; r++) { float y = acc[et][r] * fi; acc[et][r] = y; s1 += y; s2s += y * y; }
    s1 += __shfl_xor(s1, 32, 64); s2s += __shfl_xor(s2s, 32, 64);
    if (h2 == 0) { exch[(w * 32 + l31) * 2] = s1; exch[(w * 32 + l31) * 2 + 1] = s2s; }
    __syncthreads();
    {
      float o1 = exch[((w ^ 2) * 32 + l31) * 2], o2 = exch[((w ^ 2) * 32 + l31) * 2 + 1];
      float mu = (s1 + o1) * (1.0f / 128.0f);
      float var = (s2s + o2) * (1.0f / 128.0f) - mu * mu;
      float rs = rsqrtf(fmaxf(var, 0.f) + 1e-6f);
      u16* rowp = ZB + (rb + qi) * ZB_W;
#pragma unroll
      for (int et = 0; et < 2; et++)
#pragma unroll
        for (int g = 0; g < 4; g++) {
          int e = 32 * (2 * eh + et) + 8 * g + 4 * h2;
          uint2 gg = *(const uint2*)(rowp + 1536 + h * 128 + e);
          float g0 = bflo(gg.x), g1 = bfhi(gg.x), g2 = bflo(gg.y), g3 = bfhi(gg.y);
          float y0 = (acc[et][4 * g] - mu) * rs * g0 * sigmoidf_(g0);
          float y1 = (acc[et][4 * g + 1] - mu) * rs * g1 * sigmoidf_(g1);
          float y2 = (acc[et][4 * g + 2] - mu) * rs * g2 * sigmoidf_(g2);
          float y3 = (acc[et][4 * g + 3] - mu) * rs * g3 * sigmoidf_(g3);
          uint2 u = {pack2(y0, y1), pack2(y2, y3)};
          *(uint2*)(rowp + h * 128 + e) = u;
        }
    }
#pragma unroll
    for (int dt = 0; dt < 4; dt++) {
#pragma unroll
      for (int r = 0; r < 16; r++) racc[dt][r] *= g64;
    }
#pragma unroll
    for (int s = 0; s < 4; s++) {
      const int tk0 = 16 * s + 4 * h2 + q4;
      s16x4 blo = tr_read(sV + tk0 * 136 + 32 * w + 16 * gsel + 4 * p4);
      s16x4 bhi = tr_read(sV + (tk0 + 8) * 136 + 32 * w + 16 * gsel + 4 * p4);
      bf16x8 bfrag = cat44(blo, bhi);
#pragma unroll
      for (int dt = 0; dt < 4; dt++) {
        s16x4 alo = tr_read(sK + tk0 * 136 + 32 * dt + 16 * gsel + 4 * p4);
        s16x4 ahi = tr_read(sK + (tk0 + 8) * 136 + 32 * dt + 16 * gsel + 4 * p4);
        racc[dt] = MFMA(cat44(alo, ahi), bfrag, racc[dt]);
      }
    }
#pragma unroll
    for (int dt = 0; dt < 4; dt++)
#pragma unroll
      for (int g = 0; g < 4; g++) {
        uint2 u = {pack2(racc[dt][4 * g], racc[dt][4 * g + 1]), pack2(racc[dt][4 * g + 2], racc[dt][4 * g + 3])};
        *(uint2*)(sR + (32 * w + l31) * 136 + 32 * dt + 8 * g + 4 * h2) = u;
      }
    __syncthreads();
  }
}

DI void rwkv_epi(const Params& p, int b, int h, int half, int cc, int partner, const unsigned long long* xch,
                 unsigned long long g1, unsigned long long g2, unsigned tag,
                 const float* ybuf, const float* stV, const u16* stG, const float* stS, const float* par, int tid) {
  u16* YC = (u16*)(p.ws + OFF_YC);
  const int ti = tid >> 3, part = tid & 7, slot = cc & 1;
  {
    const unsigned long long* src = xch + ((size_t)(partner * 4 + (cc & 3)) * 32 + ti) * 2;
    unsigned spins = 0;
    while ((unsigned)(g1 >> 32) != tag || (unsigned)(g2 >> 32) != tag) {
      __builtin_amdgcn_s_sleep(1);
      g1 = __hip_atomic_load(src, __ATOMIC_RELAXED, __HIP_MEMORY_SCOPE_AGENT);
      g2 = __hip_atomic_load(src + 1, __ATOMIC_RELAXED, __HIP_MEMORY_SCOPE_AGENT);
      if (++spins > (1u << 22)) break;
    }
  }
  const float o1 = __uint_as_float((unsigned)(g1 & 0xffffffffull)), o2 = __uint_as_float((unsigned)(g2 & 0xffffffffull));
  const float s1 = stS[(slot * 32 + ti) * 4 + 0] + o1, s2 = stS[(slot * 32 + ti) * 4 + 1] + o2;
  const float bonus = stS[(slot * 32 + ti) * 4 + 2];
  const float mean = s1 * (1.f / 64.f);
  const float var = fmaxf(s2 * (1.f / 64.f) - mean * mean, 0.f);
  const float rsd = rsqrtf(var + 64e-5f);
  float o[4];
#pragma unroll
  for (int e = 0; e < 4; e++) {
    const int rr = part * 4 + e, c = half * 32 + rr;
    const float y = (ybuf[slot * 1024 + ti * 32 + rr] - mean) * rsd * par[8 * 64 + c] + par[9 * 64 + c] + bonus * stV[slot * 1024 + ti * 32 + rr];
    o[e] = y * bf2f(stG[slot * 1024 + ti * 32 + rr]);
  }
  uint2 u = {pack2(o[0], o[1]), pack2(o[2], o[3])};
  *(uint2*)(YC + ((size_t)b * SEQ + cc * 32 + ti) * 512 + h * 64 + half * 32 + part * 4) = u;
}

DI void rwkv_block(const Params& p, int l, int b, int h, int half, char* smem) {
  const int TX = tid_opaque();
  const u16* ZC = (const u16*)(p.ws + OFF_ZC);
  u16* YC = (u16*)(p.ws + OFF_YC);
  u16* VF = (u16*)(p.ws + OFF_VF);
  const u16* Wt = (const u16*)(p.ws + OFF_W);
  const int tid = TX, lane = tid & 63, wv = tid >> 6, l31 = lane & 31, h2 = lane >> 5;
  float* opKK = (float*)smem;
  float* opW  = opKK + 2048;
  float* opB  = opW + 2048;
  float* opK  = opB + 2048;
  float* opWR = opK + 2048;
  float* opV  = opWR + 2048;
  u16*   opG  = (u16*)(smem + 49152);
  float* scal = (float*)(smem + 53248);
  float* ybuf = (float*)(smem + 53760);
  float* par  = (float*)(smem + 61952);
  float* stV  = (float*)(smem + 64768);
  u16*   stG  = (u16*)(smem + 72960);
  float* stS  = (float*)(smem + 77056);
  const int me = (b * 8 + h) * 2 + half, partner = me ^ 1;
  unsigned long long* xch = (unsigned long long*)(p.ws + OFF_SM + SM_XCH);
  const u16* ALR = (l == 0) ? (const u16*)p.out : (const u16*)(p.ws + OFF_ACTLR);
  __syncthreads();
  {
    const float* mu = p.in[4] + l * 1792;
    if (tid < 64) {
      const int c = h * 64 + tid;
      par[0 * 64 + tid] = mu[c]; par[1 * 64 + tid] = mu[512 + c]; par[2 * 64 + tid] = mu[1024 + c];
      par[3 * 64 + tid] = p.in[5][l * 512 + c];
      par[4 * 64 + tid] = p.in[7][l * 512 + c];
      par[5 * 64 + tid] = p.in[10][l * 512 + c];
      par[6 * 64 + tid] = p.in[11][l * 512 + c];
      par[7 * 64 + tid] = p.in[12][l * 512 + c];
      par[8 * 64 + tid] = p.in[13][l * 512 + c];
      par[9 * 64 + tid] = p.in[14][l * 512 + c];
      par[10 * 64 + tid] = (l == 1) ? p.in[17][c] : 0.f;
    }
  }
  const int koff = wv * 64;
  const u16* wsrc = Wt + ((wv == 0) ? W_W2 : (wv == 1) ? W_A2 : (wv == 2) ? W_G2 : (W_G2 + 64));
  const int ldw = (wv < 2) ? 64 : 128;
  bf16x8 wf[2][4];
#pragma unroll
  for (int nt = 0; nt < 2; nt++)
#pragma unroll
    for (int s = 0; s < 4; s++) wf[nt][s] = *(const bf16x8*)(wsrc + (size_t)(h * 64 + nt * 32 + l31) * ldw + 16 * s + 8 * h2);
  f2 S[4];
#pragma unroll
  for (int j = 0; j < 4; j++) S[j] = (f2){0.f, 0.f};
  const int kq = lane & 7, rs = lane >> 3;
  const int rloc = wv * 8 + rs, vrow = half * 32 + rloc;
  const int ti = tid >> 3, c0 = (tid & 7) * 8;
  bf16x8 af0, af1, af2, af3, av0, av1;
  u32x4 pr_c, pr_p, pk_c, pk_p, pv_c, pv_p, pvf;
  const u32x4 zero4 = {0u, 0u, 0u, 0u};
  auto issue = [&](int ch) {
    const int s0 = ch * 32;
    const size_t rb = (size_t)b * SEQ + s0;
    {
      const u16* ap = ALR + (rb + l31) * 288 + koff + 8 * h2;
      af0 = *(const bf16x8*)(ap); af1 = *(const bf16x8*)(ap + 16); af2 = *(const bf16x8*)(ap + 32); af3 = *(const bf16x8*)(ap + 48);
      const bf16x8 zz = {0, 0, 0, 0, 0, 0, 0, 0};
      av0 = zz; av1 = zz;
      if (l == 1 && wv == 3) { const u16* vp = ALR + (rb + l31) * 288 + 256 + 8 * h2; av0 = *(const bf16x8*)(vp); av1 = *(const bf16x8*)(vp + 16); }
    }
    const u16* cp = ZC + (rb + ti) * ZC_W + h * 64 + c0;
    pr_c = *(const u32x4*)cp; pk_c = *(const u32x4*)(cp + 512); pv_c = *(const u32x4*)(cp + 1024);
    pr_p = zero4; pk_p = zero4; pv_p = zero4;
    if (s0 + ti > 0) { pr_p = *(const u32x4*)(cp - ZC_W); pk_p = *(const u32x4*)(cp - ZC_W + 512); pv_p = *(const u32x4*)(cp - ZC_W + 1024); }
    pvf = zero4;
    if (l == 1) pvf = *(const u32x4*)(VF + (rb + ti) * 512 + h * 64 + c0);
  };
  issue(0);
  __syncthreads();
  for (int ch = 0; ch < SEQ / 32; ch++) {
    const int s0 = ch * 32;
    const size_t rb = (size_t)b * SEQ + s0;
    const bf16x8 caf0 = af0, caf1 = af1, caf2 = af2, caf3 = af3, cav0 = av0, cav1 = av1;
    float zr[8], zk[8], zv[8], vfv[8];
    {
      float a[8], bb[8];
      unpack8(pr_c, a); unpack8(pr_p, bb);
#pragma unroll
      for (int e = 0; e < 8; e++) zr[e] = a[e] + (bb[e] - a[e]) * par[0 * 64 + c0 + e];
      unpack8(pk_c, a); unpack8(pk_p, bb);
#pragma unroll
      for (int e = 0; e < 8; e++) zk[e] = a[e] + (bb[e] - a[e]) * par[1 * 64 + c0 + e];
      unpack8(pv_c, a); unpack8(pv_p, bb);
#pragma unroll
      for (int e = 0; e < 8; e++) zv[e] = a[e] + (bb[e] - a[e]) * par[2 * 64 + c0 + e];
      unpack8(pvf, vfv);
    }
    {
      f32x16 pa[2];
#pragma unroll
      for (int nt = 0; nt < 2; nt++)
#pragma unroll
        for (int r = 0; r < 16; r++) pa[nt][r] = 0.f;
      pa[0] = MFMA(caf0, wf[0][0], pa[0]); pa[1] = MFMA(caf0, wf[1][0], pa[1]);
      pa[0] = MFMA(caf1, wf[0][1], pa[0]); pa[1] = MFMA(caf1, wf[1][1], pa[1]);
      pa[0] = MFMA(caf2, wf[0][2], pa[0]); pa[1] = MFMA(caf2, wf[1][2], pa[1]);
      pa[0] = MFMA(caf3, wf[0][3], pa[0]); pa[1] = MFMA(caf3, wf[1][3], pa[1]);
      float* dst = (wv == 0) ? opW : (wv == 1) ? opB : (wv == 2) ? opKK : opK;
#pragma unroll
      for (int nt = 0; nt < 2; nt++)
#pragma unroll
        for (int r = 0; r < 16; r++) dst[crow(r, h2) * 64 + nt * 32 + l31] = pa[nt][r];
      if (l == 1 && wv == 3) {
#pragma unroll
        for (int nt = 0; nt < 2; nt++)
#pragma unroll
          for (int r = 0; r < 16; r++) pa[nt][r] = 0.f;
#pragma unroll
        for (int nt = 0; nt < 2; nt++) {
          bf16x8 w0v = *(const bf16x8*)(Wt + W_V2 + (size_t)(h * 64 + nt * 32 + l31) * 32 + 8 * h2);
          bf16x8 w1v = *(const bf16x8*)(Wt + W_V2 + (size_t)(h * 64 + nt * 32 + l31) * 32 + 16 + 8 * h2);
          pa[nt] = MFMA(cav0, w0v, pa[nt]);
          pa[nt] = MFMA(cav1, w1v, pa[nt]);
        }
#pragma unroll
        for (int nt = 0; nt < 2; nt++)
#pragma unroll
          for (int r = 0; r < 16; r++) opV[crow(r, h2) * 64 + nt * 32 + l31] = pa[nt][r];
      }
    }
    lds_barrier();
    {
      typedef float f4 __attribute__((ext_vector_type(4)));
      u32x4 gu;
      float dec[8], av[8];
#define LD8(dst, ptr) do { const f4 t0_ = *(const f4*)(ptr); const f4 t1_ = *(const f4*)((ptr) + 4); \
        dst[0] = t0_[0]; dst[1] = t0_[1]; dst[2] = t0_[2]; dst[3] = t0_[3]; dst[4] = t1_[0]; dst[5] = t1_[1]; dst[6] = t1_[2]; dst[7] = t1_[3]; } while (0)
#define ST8(ptr, src) do { f4 t0_ = {src[0], src[1], src[2], src[3]}; f4 t1_ = {src[4], src[5], src[6], src[7]}; \
        *(f4*)(ptr) = t0_; *(f4*)((ptr) + 4) = t1_; } while (0)
      {
        float g0[8], g1[8], wpre[8], apre[8], pw0[8], pa0[8];
        LD8(g0, opKK + ti * 64 + c0); LD8(g1, opK + ti * 64 + c0);
        LD8(wpre, opW + ti * 64 + c0); LD8(apre, opB + ti * 64 + c0);
        LD8(pw0, par + 3 * 64 + c0); LD8(pa0, par + 4 * 64 + c0);
        gu = (u32x4){pack2(g0[0] + g1[0], g0[1] + g1[1]), pack2(g0[2] + g1[2], g0[3] + g1[3]),
                     pack2(g0[4] + g1[4], g0[5] + g1[5]), pack2(g0[6] + g1[6], g0[7] + g1[7])};
#pragma unroll
        for (int e = 0; e < 8; e++) {
          dec[e] = __expf(-0.6065306597126334f * fsig(wpre[e] + pw0[e]));
          av[e] = fsig(apre[e] + pa0[e]);
        }
      }
      float ssq = 0.f, brs = 0.f, krs = 0.f, bns = 0.f;
      float kkr[8], dwr[8], kpv[8];
      const size_t grow = rb + ti;
      {
        float vgp[8], pkk[8], pka[8], prk[8], pv0[8];
        LD8(vgp, opV + ti * 64 + c0); LD8(pkk, par + 5 * 64 + c0);
        LD8(pka, par + 6 * 64 + c0); LD8(prk, par + 7 * 64 + c0); LD8(pv0, par + 10 * 64 + c0);
#pragma unroll
        for (int e = 0; e < 8; e++) {
          float vv = zv[e];
          if (l == 1) vv = vv + (vfv[e] - vv) * fsig(pv0[e] + vgp[e]);
          zv[e] = vv;
          kkr[e] = zk[e] * pkk[e];
          ssq += kkr[e] * kkr[e];
          const float kp = zk[e] * (1.f + (av[e] - 1.f) * pka[e]);
          dwr[e] = dec[e] * zr[e]; kpv[e] = kp;
          krs += kp * zr[e];
          bns += zr[e] * kp * prk[e];
        }
      }
      ssq = red8(ssq);
      const float inv = (ssq > 1e-24f) ? rsqrtf(ssq) : 1e12f;
      float kkv[8], bvv[8];
#pragma unroll
      for (int e = 0; e < 8; e++) { kkv[e] = kkr[e] * inv; bvv[e] = kkv[e] * av[e]; brs += bvv[e] * zr[e]; }
      brs = red8(brs); krs = red8(krs); bns = red8(bns);
      *(u32x4*)(opG + ti * 64 + c0) = gu;
      ST8(opW + ti * 64 + c0, dec); ST8(opWR + ti * 64 + c0, dwr); ST8(opK + ti * 64 + c0, kpv); ST8(opV + ti * 64 + c0, zv);
      ST8(opKK + ti * 64 + c0, kkv); ST8(opB + ti * 64 + c0, bvv);
      if ((tid & 7) == 0) { scal[ti] = brs; scal[32 + ti] = krs; scal[64 + ti] = bns; }
      if (l == 0 && half == 0) {
        u32x4 u = {pack2(zv[0], zv[1]), pack2(zv[2], zv[3]), pack2(zv[4], zv[5]), pack2(zv[6], zv[7])};
        *(u32x4*)(VF + grow * 512 + h * 64 + c0) = u;
      }
#undef LD8
#undef ST8
    }
    lds_barrier();
    unsigned long long pg1 = 0ull, pg2 = 0ull;
    if (ch >= 1) {
      const unsigned long long* src = xch + ((size_t)(partner * 4 + ((ch - 1) & 3)) * 32 + ti) * 2;
      pg1 = __hip_atomic_load(src, __ATOMIC_RELAXED, __HIP_MEMORY_SCOPE_AGENT);
      pg2 = __hip_atomic_load(src + 1, __ATOMIC_RELAXED, __HIP_MEMORY_SCOPE_AGENT);
    }
    if (ch + 1 < SEQ / 32) issue(ch + 1);
    float* yb = ybuf + (ch & 1) * 1024;
#define SCAN_STEP(T, YOUT) do { \
      const f2* pkk = (const f2*)(opKK + (T) * 64 + 8 * kq); const f2* pw = (const f2*)(opW + (T) * 64 + 8 * kq); \
      const f2* pb = (const f2*)(opB + (T) * 64 + 8 * kq); const f2* pk = (const f2*)(opK + (T) * 64 + 8 * kq); \
      const f2* pwr = (const f2*)(opWR + (T) * 64 + 8 * kq); \
      const float vv = opV[(T) * 64 + vrow]; const float br = scal[(T)], kr = scal[32 + (T)]; \
      f2 kk4[4], w4[4], b4[4], k4[4], wr4[4]; \
      _Pragma("unroll") for (int j = 0; j < 4; j++) { kk4[j] = pkk[j]; w4[j] = pw[j]; b4[j] = pb[j]; k4[j] = pk[j]; wr4[j] = pwr[j]; } \
      const f2 v0v = {vv, vv}; \
      f2 p0 = (S[0] * kk4[0] + S[1] * kk4[1]) + (S[2] * kk4[2] + S[3] * kk4[3]); \
      f2 q0 = (S[0] * wr4[0] + S[1] * wr4[1]) + (S[2] * wr4[2] + S[3] * wr4[3]); \
      f2 tq[4]; \
      _Pragma("unroll") for (int j = 0; j < 4; j++) tq[j] = S[j] * w4[j] + v0v * k4[j];     \
      const float P0 = red8(p0[0] + p0[1]), Q0 = red8(q0[0] + q0[1]); \
      const float sa0 = -P0; const f2 sa0v = {sa0, sa0}; \
      _Pragma("unroll") for (int j = 0; j < 4; j++) S[j] = sa0v * b4[j] + tq[j]; \
      YOUT = Q0 + sa0 * br + vv * kr; } while (0)
#pragma unroll 1
    for (int t = 0; t < 32; t += 4) {
      float y0_, y1_, y2_, y3_;
      SCAN_STEP(t, y0_);
      SCAN_STEP(t + 1, y1_);
      SCAN_STEP(t + 2, y2_);
      SCAN_STEP(t + 3, y3_);
      yb[t * 32 + rloc] = y0_; yb[(t + 1) * 32 + rloc] = y1_; yb[(t + 2) * 32 + rloc] = y2_; yb[(t + 3) * 32 + rloc] = y3_;
    }
#undef SCAN_STEP
    lds_barrier();
    {
      const int part = tid & 7, slot = ch & 1;
      float s1 = 0.f, s2 = 0.f;
      float yv_[4], vv_[4]; u16 gg_[4];
#pragma unroll
      for (int e = 0; e < 4; e++) {
        const int rr = part * 4 + e;
        yv_[e] = yb[ti * 32 + rr]; vv_[e] = opV[ti * 64 + half * 32 + rr]; gg_[e] = opG[ti * 64 + half * 32 + rr];
      }
      const float bon_ = scal[64 + ti];
#pragma unroll
      for (int e = 0; e < 4; e++) {
        const int rr = part * 4 + e;
        s1 += yv_[e]; s2 += yv_[e] * yv_[e];
        stV[slot * 1024 + ti * 32 + rr] = vv_[e];
        stG[slot * 1024 + ti * 32 + rr] = gg_[e];
      }
      s1 = red8(s1); s2 = red8(s2);
      if (part == 0) {
        stS[(slot * 32 + ti) * 4 + 0] = s1; stS[(slot * 32 + ti) * 4 + 1] = s2; stS[(slot * 32 + ti) * 4 + 2] = bon_;
        const unsigned long long tg = (unsigned long long)(unsigned)(ch + 1) << 32;
        unsigned long long* dst = xch + ((size_t)(me * 4 + (ch & 3)) * 32 + ti) * 2;
        __hip_atomic_store(dst, tg | (unsigned long long)__float_as_uint(s1), __ATOMIC_RELAXED, __HIP_MEMORY_SCOPE_AGENT);
        __hip_atomic_store(dst + 1, tg | (unsigned long long)__float_as_uint(s2), __ATOMIC_RELAXED, __HIP_MEMORY_SCOPE_AGENT);
      }
    }
    lds_barrier();
    if (ch >= 1) rwkv_epi(p, b, h, half, ch - 1, partner, xch, pg1, pg2, (unsigned)ch, ybuf, stV, stG, stS, par, tid);
  }
  lds_barrier();
  rwkv_epi(p, b, h, half, SEQ / 32 - 1, partner, xch, 0ull, 0ull, (unsigned)(SEQ / 32), ybuf, stV, stG, stS, par, tid);
  lds_barrier();
}

DI void phase_mixers(const Params& p, int l, char* smem) {
  const int TX = tid_opaque();
  const int bid = blockIdx.x;
  int* cnt = (int*)(p.ws + OFF_SM + SM_CNT);
  __shared__ int s_item;
  if (EN_RWKV && bid < 128) { rwkv_block(p, l, bid >> 4, (bid >> 1) & 7, bid & 1, smem); }
  else if (EN_RET && bid >= 128 && bid < 160) { int i = bid - 128; retention_block(p, i >> 2, i & 3, smem); }
  if (!EN_ATT) return;
  for (;;) {
    __syncthreads();
    if (TX == 0) s_item = atomicAdd(cnt, 1);
    __syncthreads();
    int it = s_item;
    if (it >= 2048) break;
    int qt = 31 - (it >> 6), bh = it & 63;
    attn_item(p, bh >> 3, bh & 7, qt, smem);
  }
}

DI void phase_merge(const Params& p, char* smem) {
  const int TX = tid_opaque();
  const u16* XB = (const u16*)(p.ws + OFF_XB);
  const u16* W = (const u16*)(p.ws + OFF_W);
  const float* rstd = (const float*)(p.ws + OFF_SM + SM_RSTD);
  u16* MG = (u16*)(p.ws + OFF_MERGED);
  const int lane = TX & 63, w = TX >> 6, wr = w >> 1, wc = w & 1, l31 = lane & 31, h2 = lane >> 5;
  const int ntiles = 256 * 8;
  u16* T = (u16*)smem;
  for (int t = blockIdx.x; t < ntiles; t += gridDim.x) {
    int m0, n0; tile_coords(t, 8, m0, n0);
    bool first = true;
#pragma unroll 1
    for (int n = 0; n < 3; n++) {
      bool en = (n == 0) ? (EN_ATT != 0) : (n == 1) ? (EN_RET != 0) : (EN_RWKV != 0);
      if (!en) continue;
      f32x16 acc[2][2]; zero_acc<2>(acc);
      gemm_tile<2>(XB, 1024, W + W_G + (size_t)n * 1024 * 1024, 1024, 1024, m0, n0, acc, smem);
      unsigned gtp[2][2][8];
      {
        float rs[2][16];
#pragma unroll
        for (int mi = 0; mi < 2; mi++)
#pragma unroll
          for (int r = 0; r < 16; r++) rs[mi][r] = rstd[m0 + wr * 64 + mi * 32 + crow(r, h2)];
#pragma unroll
        for (int mi = 0; mi < 2; mi++)
#pragma unroll
          for (int ni = 0; ni < 2; ni++)
#pragma unroll
            for (int q = 0; q < 8; q++)
              gtp[mi][ni][q] = pack2(fsig(acc[mi][ni][2 * q] * rs[mi][2 * q]), fsig(acc[mi][ni][2 * q + 1] * rs[mi][2 * q + 1]));
      }
      zero_acc<2>(acc);
      const u16* Y; int ldy;
      if (n == 0) { Y = (const u16*)(p.ws + OFF_ZA); ldy = ZA_W; }
      else if (n == 1) { Y = (const u16*)(p.ws + OFF_ZB); ldy = ZB_W; }
      else { Y = (const u16*)(p.ws + OFF_YC); ldy = 512; }
      gemm_tile<2>(Y, ldy, W + W_BR + (size_t)n * 1024 * 512, 512, 512, m0, n0, acc, smem);
#pragma unroll
      for (int mi = 0; mi < 2; mi++)
#pragma unroll
        for (int ni = 0; ni < 2; ni++)
#pragma unroll
          for (int r = 0; r < 16; r++) {
            const unsigned g = gtp[mi][ni][r >> 1];
            const float gv = (r & 1) ? bfhi(g) : bflo(g);
            T[(wr * 64 + mi * 32 + crow(r, h2)) * 136 + wc * 64 + ni * 32 + l31] = f2bf(gv * acc[mi][ni][r]);
          }
      __syncthreads();
      {
#pragma unroll 1
        for (int hh = 0; hh < 2; hh++) {
          u32x4 tv[4], ov[4];
#pragma unroll
          for (int i = 0; i < 4; i++) {
            const int idx = TX + 256 * (hh * 4 + i), row = idx >> 4, chn = idx & 15;
            tv[i] = *(const u32x4*)(T + row * 136 + chn * 8);
            ov[i] = (u32x4){0u, 0u, 0u, 0u};
            if (!first) ov[i] = *(const u32x4*)(MG + (size_t)(m0 + row) * 1024 + n0 + chn * 8);
          }
#pragma unroll
          for (int i = 0; i < 4; i++) {
            const int idx = TX + 256 * (hh * 4 + i), row = idx >> 4, chn = idx & 15;
            u32x4 o;
#pragma unroll
            for (int q = 0; q < 4; q++) o[q] = pack2(bflo(tv[i][q]) + bflo(ov[i][q]), bfhi(tv[i][q]) + bfhi(ov[i][q]));
            *(u32x4*)(MG + (size_t)(m0 + row) * 1024 + n0 + chn * 8) = o;
          }
        }
      }
      first = false;
    }
  }
}

DI void phase_resid(const Params& p, const u16* A, int lda, const u16* Bt, int K, const float* xin, float* xout, char* smem) {
  const int TX = tid_opaque();
  const int lane = TX & 63, w = TX >> 6, wr = w >> 1, wc = w & 1, l31 = lane & 31, h2 = lane >> 5;
  const int ntiles = 256 * 8;
  for (int t = blockIdx.x; t < ntiles; t += gridDim.x) {
    int m0, n0; tile_coords(t, 8, m0, n0);
    f32x16 acc[2][2]; zero_acc<2>(acc);
    gemm_tile<2>(A, lda, Bt, K, K, m0, n0, acc, smem);
    float xv[2][2][16];
#pragma unroll
    for (int mi = 0; mi < 2; mi++)
#pragma unroll
      for (int ni = 0; ni < 2; ni++)
#pragma unroll
        for (int r = 0; r < 16; r++) xv[mi][ni][r] = xin[(size_t)(m0 + wr * 64 + mi * 32 + crow(r, h2)) * 1024 + n0 + wc * 64 + ni * 32 + l31];
#pragma unroll
    for (int mi = 0; mi < 2; mi++)
#pragma unroll
      for (int ni = 0; ni < 2; ni++)
#pragma unroll
        for (int r = 0; r < 16; r++) xout[(size_t)(m0 + wr * 64 + mi * 32 + crow(r, h2)) * 1024 + n0 + wc * 64 + ni * 32 + l31] = xv[mi][ni][r] + acc[mi][ni][r];
  }
}

DI void phase_gateup(const Params& p, char* smem) {
  const int TX = tid_opaque();
  const u16* XB = (const u16*)(p.ws + OFF_XB);
  const u16* W = (const u16*)(p.ws + OFF_W) + W_GU;
  const float* rstd = (const float*)(p.ws + OFF_SM + SM_RSTD);
  u16* ACT = (u16*)(p.ws + OFF_ACT);
  const int lane = TX & 63, w = TX >> 6, wr = w >> 1, wc = w & 1, l31 = lane & 31, h2 = lane >> 5;
  const int ntiles = 256 * 44;
  u32x4 pa[2][4], pb[2][4];
  int t = blockIdx.x, m0 = 0, n0 = 0;
  if (t < ntiles) { tile_coords(t, 44, m0, n0); gemm_pref<2>(XB, 1024, W, 1024, m0, n0, pa, pb); }
  for (; t < ntiles; t += gridDim.x) {
    f32x16 acc[2][2]; zero_acc<2>(acc);
    gemm_main<2>(XB, 1024, W, 1024, 1024, m0, n0, acc, smem, pa, pb);
    const int em0 = m0, en0 = n0;
    float rs[2][16];
#pragma unroll
    for (int mi = 0; mi < 2; mi++)
#pragma unroll
      for (int r = 0; r < 16; r++) rs[mi][r] = rstd[em0 + wr * 64 + mi * 32 + crow(r, h2)];
    if (t + (int)gridDim.x < ntiles) { tile_coords(t + gridDim.x, 44, m0, n0); gemm_pref<2>(XB, 1024, W, 1024, m0, n0, pa, pb); }
    u16* T = (u16*)smem;
#pragma unroll
    for (int mi = 0; mi < 2; mi++)
#pragma unroll
      for (int r = 0; r < 16; r++) {
        const float g = acc[mi][0][r] * rs[mi][r], u = acc[mi][1][r] * rs[mi][r];
        T[(wr * 64 + mi * 32 + crow(r, h2)) * 72 + wc * 32 + l31] = f2bf(g * fsig(g) * u);
      }
    __syncthreads();
    {
      u16* dst = ACT + (size_t)em0 * DFF + (en0 >> 7) * 64;
      u32x4 tv[4];
#pragma unroll
      for (int i = 0; i < 4; i++) { const int idx = TX + 256 * i; tv[i] = *(const u32x4*)(T + (idx >> 3) * 72 + (idx & 7) * 8); }
#pragma unroll
      for (int i = 0; i < 4; i++) { const int idx = TX + 256 * i; *(u32x4*)(dst + (size_t)(idx >> 3) * DFF + (idx & 7) * 8) = tv[i]; }
    }
  }
}

DI void phase_ple(const Params& p, char* smem) {
  const int TX = tid_opaque();
  const u16* XB = (const u16*)(p.ws + OFF_XB);
  const u16* PB = (const u16*)(p.ws + OFF_PB);
  const u16* W = (const u16*)(p.ws + OFF_W);
  const float* rstd = (const float*)(p.ws + OFF_SM + SM_RSTD);
  const int lane = TX & 63, w = TX >> 6, wr = w >> 1, wc = w & 1, l31 = lane & 31, h2 = lane >> 5;
  const int ntiles = 256 * 8;
  for (int t = blockIdx.x; t < ntiles; t += gridDim.x) {
    int m0, n0; tile_coords(t, 8, m0, n0);
    f32x16 acc[2][2]; zero_acc<2>(acc);
    gemm_tile<2>(PB, 256, W + W_PP, 256, 256, m0, n0, acc, smem);
    unsigned pp[2][2][8];
#pragma unroll
    for (int mi = 0; mi < 2; mi++)
#pragma unroll
      for (int ni = 0; ni < 2; ni++)
#pragma unroll
        for (int q = 0; q < 8; q++) pp[mi][ni][q] = pack2(acc[mi][ni][2 * q], acc[mi][ni][2 * q + 1]);
    zero_acc<2>(acc);
    gemm_tile<2>(XB, 1024, W + W_PG, 1024, 1024, m0, n0, acc, smem);
#pragma unroll
    for (int mi = 0; mi < 2; mi++) {
      float rs[16], xv[2][16];
#pragma unroll
      for (int r = 0; r < 16; r++) rs[r] = rstd[m0 + wr * 64 + mi * 32 + crow(r, h2)];
#pragma unroll
      for (int ni = 0; ni < 2; ni++)
#pragma unroll
        for (int r = 0; r < 16; r++) xv[ni][r] = p.out[(size_t)(m0 + wr * 64 + mi * 32 + crow(r, h2)) * 1024 + n0 + wc * 64 + ni * 32 + l31];
#pragma unroll
      for (int ni = 0; ni < 2; ni++)
#pragma unroll
        for (int r = 0; r < 16; r++) {
          const unsigned pu = pp[mi][ni][r >> 1];
          const float pv = (r & 1) ? bfhi(pu) : bflo(pu);
          p.out[(size_t)(m0 + wr * 64 + mi * 32 + crow(r, h2)) * 1024 + n0 + wc * 64 + ni * 32 + l31] = xv[ni][r] + pv * fsig(acc[mi][ni][r] * rs[r]);
        }
    }
  }
}

#define XB_TMO      128
#define XB_XCNT(j)  (256  + 64 * (j))
#define XB_XSUB(j)  (1280 + 64 * (j))
#define XB_XGEN(j)  (2304 + 64 * (j))
#define XB_TOP      3328
#define XB_TOPGEN   3392
#define XCD_BAR_WORDS 3456
#define XB_SPIN_CAP (1u << 18)
#define LAS __attribute__((address_space(3)))

__device__ __forceinline__ unsigned xb_ld(unsigned* p)              { return __hip_atomic_load(p, __ATOMIC_RELAXED, __HIP_MEMORY_SCOPE_AGENT); }
__device__ __forceinline__ unsigned xb_add(unsigned* p, unsigned v) { return __hip_atomic_fetch_add(p, v, __ATOMIC_RELAXED, __HIP_MEMORY_SCOPE_AGENT); }
__device__ __forceinline__ unsigned xb_xcc_id() { return (unsigned)__builtin_amdgcn_s_getreg((3 << 11) | 20) & 0xFu; }
#define XB_SPIN(cond, bar) do { unsigned _sp = 0; while (cond) { __builtin_amdgcn_s_sleep(1); \
    if ((++_sp & 255u) == 0u) { if (xb_ld(&(bar)[XB_TMO])) break; if (_sp > XB_SPIN_CAP) { atomicAdd(&(bar)[XB_TMO], 1u); break; } } } } while (0)

struct XcdBarrier {
    unsigned* bar; unsigned x;
    volatile LAS unsigned* st;
};

__device__ __forceinline__ XcdBarrier xcd_barrier_post(unsigned* bar, volatile LAS unsigned* st) {
    XcdBarrier b; b.bar = bar; b.x = xb_xcc_id(); b.st = st;
    if (threadIdx.x == 0) (void)xb_add(&bar[XB_XCNT(b.x)], 1u);
    return b;
}
__device__ __forceinline__ void xcd_barrier_complete(unsigned* bar, unsigned x, unsigned& nloc, unsigned& nx) {
    const unsigned G = gridDim.x * gridDim.y * gridDim.z;
    unsigned sum, cnt, mine, sp = 0u;
    for (;;) {
        sum = 0u; cnt = 0u; mine = 0u;
#pragma unroll
        for (unsigned j = 0; j < 16; ++j) { const unsigned c = xb_ld(&bar[XB_XCNT(j)]); sum += c; cnt += (c > 0u) ? 1u : 0u; mine = (j == x) ? c : mine; }
        if (sum == G) break;
        __builtin_amdgcn_s_sleep(1);
        if ((++sp & 255u) == 0u) { if (xb_ld(&bar[XB_TMO])) break; if (sp > XB_SPIN_CAP) { atomicAdd(&bar[XB_TMO], 1u); break; } }
    }
    nloc = mine > 0u ? mine : 1u; nx = cnt > 0u ? cnt : 1u;
}

__device__ __forceinline__ void xcd_barrier(const XcdBarrier& b) {
    asm volatile("s_waitcnt vmcnt(0)" ::: "memory");
    __syncthreads();
    if (threadIdx.x == 0) {
        unsigned* bar = b.bar;
        __builtin_amdgcn_s_waitcnt(0);
        unsigned nloc = b.st[0], nx = b.st[1];
        if (nloc == 0u) { xcd_barrier_complete(bar, b.x, nloc, nx); b.st[0] = nloc; b.st[1] = nx; }
        const unsigned old = xb_add(&bar[XB_XSUB(b.x)], 1u);
        const unsigned gen = old / nloc;
        if (old + 1u == (gen + 1u) * nloc) {
            __builtin_amdgcn_fence(__ATOMIC_RELEASE, "agent");
            asm volatile("s_waitcnt vmcnt(0)" ::: "memory");
            const unsigned og = xb_add(&bar[XB_TOP], 1u);
            const unsigned tg = og / nx;
            if (og + 1u == (tg + 1u) * nx) xb_add(&bar[XB_TOPGEN], 1u);
            else XB_SPIN(xb_ld(&bar[XB_TOPGEN]) == tg, bar);
            __builtin_amdgcn_fence(__ATOMIC_ACQUIRE, "agent");
            xb_add(&bar[XB_XGEN(b.x)], 1u);
            asm volatile("s_waitcnt vmcnt(0)" ::: "memory");
        } else {
            XB_SPIN(xb_ld(&bar[XB_XGEN(b.x)]) == gen, bar);
            __builtin_amdgcn_fence(__ATOMIC_ACQUIRE, "agent");
            asm volatile("s_waitcnt vmcnt(0)" ::: "memory");
        }
    }
    __syncthreads();
}

template <int L>
DI void run_layer(const Params& p, char* smem, cg::grid_group& grid, const XcdBarrier& xb) {
  const float* xin = (L == 0) ? p.in[0] : p.out;
  phase_convw(p, L);
  phase_prep(p, xin, nullptr);
  if (L == 0) { grid.sync(); if (threadIdx.x == 0) (void)xb_add(&xb.bar[XB_XCNT(xb.x)], 1u); }
  else xcd_barrier(xb);
  phase_inproj(p, L, smem);
  xcd_barrier(xb);
  phase_kmean(p, smem);
  phase_lrprep(p, L);
  xcd_barrier(xb);
  phase_mixers(p, L, smem);
  xcd_barrier(xb);
  if (L == 1) { phase_prep(p, xin, nullptr); xcd_barrier(xb); }
  phase_merge(p, smem);
  xcd_barrier(xb);
  phase_resid(p, (const u16*)(p.ws + OFF_MERGED), 1024, (const u16*)(p.ws + OFF_W) + W_OUT, 1024, xin, p.out, smem);
  xcd_barrier(xb);
  phase_prep(p, p.out, nullptr);
  xcd_barrier(xb);
  phase_gateup(p, smem);
  xcd_barrier(xb);
  phase_resid(p, (const u16*)(p.ws + OFF_ACT), DFF, (const u16*)(p.ws + OFF_W) + W_DN, DFF, p.out, p.out, smem);
  xcd_barrier(xb);
  phase_prep(p, p.out, p.in[1] + (size_t)L * T_TOK * 256);
  xcd_barrier(xb);
  phase_ple(p, smem);
  xcd_barrier(xb);
}

__global__ void __launch_bounds__(NTHR, 2) fwd_megakernel(Params p) {
  cg::grid_group grid = cg::this_grid();
  __shared__ __attribute__((aligned(16))) char smem[SMEM_BYTES];
  __shared__ uint4 xb_words;
  if (threadIdx.x == 0) xb_words = make_uint4(0u, 0u, 0u, 0u);
  __syncthreads();
  XcdBarrier xb; xb.bar = (unsigned*)(p.ws + OFF_SM + SM_BAR); xb.x = xb_xcc_id(); xb.st = (volatile LAS unsigned*)&xb_words;
  if (blockIdx.x == 0) for (int i = threadIdx.x; i < XCD_BAR_WORDS; i += NTHR) xb.bar[i] = 0u;
  run_layer<0>(p, smem, grid, xb);
  run_layer<1>(p, smem, grid, xb);
  phase_final(p);
}

extern "C" void kernel_launch(void* const* d_in, const int* in_sizes, int n_in, void* d_out, int out_size,
                              void* d_ws, size_t ws_size, hipStream_t stream) {
  static int grid_blocks = 0;
  if (!grid_blocks) {
    int dev = 0, cus = 0, per_cu = 0;
    (void)hipGetDevice(&dev);
    (void)hipDeviceGetAttribute(&cus, hipDeviceAttributeMultiprocessorCount, dev);
    (void)hipOccupancyMaxActiveBlocksPerMultiprocessor(&per_cu, fwd_megakernel, NTHR, 0);
    if (per_cu > 2) per_cu = 2;
    if (per_cu < 1) per_cu = 1;
    grid_blocks = cus * per_cu;
  }
  Params p{};
  for (int i = 0; i < 28; i++) p.in[i] = (const float*)d_in[i];
  p.out = (float*)d_out;
  p.ws = (char*)d_ws;
  void* args[] = {&p};
  hipError_t e = hipLaunchCooperativeKernel((void*)fwd_megakernel, dim3(grid_blocks), dim3(NTHR), args, 0, stream);
  if (e != hipSuccess) fprintf(stderr, "cooperative launch failed: %s (grid %d)\n", hipGetErrorString(e), grid_blocks);
}
```
